# Optimizing an MI355X kernel written in HIP

```python
import math
import jax
import jax.numpy as jnp
from jax import lax
import numpy as np

D_MODEL = 1024
BATCH = 4
SEQ = 8192
DEPTH = 2

CTX_LEN = 256
GRID_W = 64
N_MOD = 9
D_FF = 2816
RMS_EPS = 1e-6

HG_HEADS = 4
HG_DK = 128
HG_DV = 128
HG_K = HG_HEADS * HG_DK
HG_V = HG_HEADS * HG_DV
HG_CHUNK = 64

HY_W = 512
HY_ORDER = 2
HY_EMB = 33
HY_BANDS = (HY_EMB - 1) // 2
HY_FH = 64
HY_TARGET = 1e-2
HY_MIN_DECAY = math.log(HY_TARGET) / 1.5
HY_MAX_DECAY = math.log(HY_TARGET) / 0.3
HY_SHIFT = 0.05

MLA_HEADS = 4
MLA_Q_LORA = 256
MLA_KV_LORA = 128
MLA_NOPE = 128
MLA_ROPE = 64
MLA_V = 128
MLA_QK = MLA_NOPE + MLA_ROPE
MLA_OUT = MLA_HEADS * MLA_V
MLA_SCALE = MLA_QK ** -0.5
ROPE_THETA = 10000.0
Q_BLOCK = 128

IN_SPLITS = (HG_K, HG_K, HG_K, HG_V, HG_V, 3 * HY_W, MLA_Q_LORA, MLA_KV_LORA, MLA_ROPE, D_MODEL, D_MODEL, D_MODEL)
IN_COLS = sum(IN_SPLITS)

kernel_name = 'hybrid_hgrn2_hyena_mla_dit_block'


def rmsnorm(x, g):
    xf = x.astype(jnp.float32)
    y = xf * lax.rsqrt(jnp.mean(xf * xf, axis=-1, keepdims=True) + RMS_EPS)
    return (y * g.astype(jnp.float32)).astype(x.dtype)


def adaln(x, g, shift, scale):
    return rmsnorm(x, g) * (1 + scale) + shift


def swiglu(h, w13, w2):
    a, b = jnp.split(h @ w13, 2, axis=-1)
    return (jax.nn.silu(a) * b) @ w2


def short_conv3(u, w, b):
    up = jnp.pad(u, ((0, 0), (1, 1), (0, 0)))
    return up[:, :-2] * w[0] + up[:, 1:-1] * w[1] + up[:, 2:] * w[2] + b


def gla_scan(q, k, v, logf, s0):
    bsz, t_len, n_h, dk = q.shape
    nc = t_len // HG_CHUNK

    def to_chunks(a):
        a = a.astype(jnp.float32).reshape(bsz, nc, HG_CHUNK, n_h, a.shape[-1])
        return jnp.moveaxis(a, (1, 3), (0, 2))

    tri = jnp.tril(jnp.ones((HG_CHUNK, HG_CHUNK), bool))[:, :, None]

    def step(state, inp):
        qc, kc, vc, gc = inp
        b = jnp.cumsum(gc, axis=2)
        b_last = b[:, :, -1:, :]
        o_inter = jnp.einsum('bhtk,bhkv->bhtv', qc * jnp.exp(b), state)
        diff = b[:, :, :, None, :] - b[:, :, None, :, :]
        decay = jnp.where(tri, jnp.exp(jnp.where(tri, diff, 0.0)), 0.0)
        attn = jnp.einsum('bhtsk,bhsk->bhts', decay * qc[:, :, :, None, :], kc)
        o = o_inter + jnp.einsum('bhts,bhsv->bhtv', attn, vc)
        new_state = jnp.exp(b_last[:, :, 0, :])[..., None] * state + jnp.einsum(
            'bhsk,bhsv->bhkv', kc * jnp.exp(b_last - b), vc)
        return new_state, o

    s_final, o = lax.scan(step, s0.astype(jnp.float32), (to_chunks(q), to_chunks(k), to_chunks(v), to_chunks(logf)))
    o = jnp.moveaxis(o, (0, 2), (1, 3)).reshape(bsz, t_len, n_h, v.shape[-1])
    return o, s_final


def split_heads(a, d):
    return a.reshape(a.shape[0], a.shape[1], -1, d)


def hgrn2_gates(z, lb):
    f = lb + (1.0 - lb) * jax.nn.sigmoid(z.astype(jnp.float32))
    return 1.0 - f, jnp.log(f)


def hgrn2_seq(q, i, zf, zb, lb_f, lb_b, s0f, s0b):
    qh = split_heads(jax.nn.silu(q), HG_DK) * HG_DK ** -0.5
    ih = split_heads(i, HG_DV)
    kf, lf = hgrn2_gates(split_heads(zf, HG_DK), lb_f.reshape(HG_HEADS, HG_DK))
    kb, lbk = hgrn2_gates(split_heads(zb, HG_DK), lb_b.reshape(HG_HEADS, HG_DK))
    o_f, s_f = gla_scan(qh, kf, ih, lf, s0f)
    flip = lambda a: jnp.flip(a, axis=1)
    o_b, s_b = gla_scan(flip(qh), flip(kb), flip(ih), flip(lbk), s0b)
    return o_f + flip(o_b), s_f, s_b


def hgrn2_readout(o, g, gain):
    o = rmsnorm(o, gain)
    return o.reshape(o.shape[0], o.shape[1], HG_V).astype(g.dtype) * jax.nn.silu(g)


def hyena_filters(L, p):
    f32 = jnp.float32
    t = jnp.linspace(0.0, 1.0, L, dtype=f32)[:, None]
    w = (2.0 * math.pi / L) * jnp.arange(L, dtype=f32)[:, None]
    bands = jnp.linspace(1e-4, HY_BANDS - 1, HY_BANDS, dtype=f32)[None, :]
    emb = jnp.concatenate([t, jnp.cos(bands * w), -jnp.sin(bands * w)], axis=-1)
    freq = p['hy_freq'].astype(f32)
    hid = jnp.sin(freq * (emb @ p['hy_w1'].astype(f32) + p['hy_b1'].astype(f32)))
    hid = jnp.sin(freq * (hid @ p['hy_w2'].astype(f32) + p['hy_b2'].astype(f32)))
    hid = jnp.sin(freq * (hid @ p['hy_w3'].astype(f32) + p['hy_b3'].astype(f32)))
    h = (hid @ p['hy_w4'].astype(f32)).reshape(L, 2, HY_ORDER, HY_W)
    deltas = jnp.abs(jnp.linspace(HY_MIN_DECAY, HY_MAX_DECAY, HY_W, dtype=f32))
    h = h * (jnp.exp(-t[:, :, None, None] * deltas) + HY_SHIFT)
    h_fwd = h[:, 0]
    h_bwd = h[1:, 1]
    norm = jnp.sum(jnp.abs(h_fwd), axis=0) + jnp.sum(jnp.abs(h_bwd), axis=0)
    k_circ = jnp.concatenate([h_fwd, jnp.zeros((1, HY_ORDER, HY_W), f32), h_bwd[::-1]], axis=0) / norm
    return jnp.fft.rfft(k_circ, axis=0)


def fft_conv(u, kf):
    L = u.shape[1]
    U = jnp.fft.rfft(u.astype(jnp.float32), n=2 * L, axis=1)
    return jnp.fft.irfft(U * kf[None], n=2 * L, axis=1)[:, :L].astype(u.dtype)


def hyena(u3, p, kf):
    uc = short_conv3(u3, p['hy_conv_w'], p['hy_conv_b'])
    x1, x2, z = jnp.split(uc, 3, axis=-1)
    for o, xg in enumerate((x1, x2)):
        z = xg * (fft_conv(z, kf[:, o]) + z * p['hy_skip'][o])
    return z


def axial_angles(L):
    rows = L // GRID_W
    row = jnp.repeat(jnp.arange(rows, dtype=jnp.float32), GRID_W)
    col = jnp.tile(jnp.arange(GRID_W, dtype=jnp.float32), rows)
    half = MLA_ROPE // 2
    inv = ROPE_THETA ** (-jnp.arange(0, half, 2, dtype=jnp.float32) / half)
    return row[:, None] * inv, col[:, None] * inv


def rotate(x, ang):
    x1, x2 = jnp.split(x, 2, axis=-1)
    cos = jnp.cos(ang).astype(x.dtype)
    sin = jnp.sin(ang).astype(x.dtype)
    return jnp.concatenate([x1 * cos - x2 * sin, x2 * cos + x1 * sin], axis=-1)


def axial_rope(x, ang_r, ang_c):
    xr, xc = jnp.split(x, 2, axis=-1)
    return jnp.concatenate([rotate(xr, ang_r), rotate(xc, ang_c)], axis=-1)


def mla_queries(qa, p):
    bsz, L, _ = qa.shape
    q = (rmsnorm(qa, p['q_a_norm']) @ p['w_uq']).reshape(bsz, L, MLA_HEADS, MLA_QK)
    return rmsnorm(q[..., :MLA_NOPE], p['q_nope_norm']), rmsnorm(q[..., MLA_NOPE:], p['q_rope_norm'])


def mla_keys(kva, kr, p):
    bsz, L, _ = kva.shape
    kv = (rmsnorm(kva, p['kv_a_norm']) @ p['w_ukv']).reshape(bsz, L, MLA_HEADS, MLA_NOPE + MLA_V)
    return rmsnorm(kv[..., :MLA_NOPE], p['k_nope_norm']), rmsnorm(kr, p['k_rope_norm']), kv[..., MLA_NOPE:]


def mla_attend(qn, qr, key_sets):
    s = jnp.concatenate([jnp.einsum('bqhd,bkhd->bhqk', qn, kn) + jnp.einsum('bqhr,bkr->bhqk', qr, kr)
                         for kn, kr, _ in key_sets], axis=-1)
    pr = jax.nn.softmax(s.astype(jnp.float32) * MLA_SCALE, axis=-1)
    out = 0.0
    start = 0
    for _, _, v in key_sets:
        n = v.shape[1]
        out = out + jnp.einsum('bhqk,bkhd->bqhd', pr[..., start:start + n].astype(v.dtype), v)
        start += n
    return out


def latent_attention(qn, qr, kn, kr, v, kn_c, kr_c, v_c):
    bsz, L = qn.shape[0], qn.shape[1]
    nb = L // Q_BLOCK
    blocks = lambda a: jnp.moveaxis(a.reshape(bsz, nb, Q_BLOCK, *a.shape[2:]), 1, 0)
    out = lax.map(lambda qb: mla_attend(qb[0], qb[1], ((kn, kr, v), (kn_c, kr_c, v_c))), (blocks(qn), blocks(qr)))
    return jnp.moveaxis(out, 0, 1).reshape(bsz, L, MLA_OUT)


def merge(y_a, y_b, y_c, g_a, g_b, g_c, p):
    m = (jax.nn.sigmoid(g_a) * (y_a @ p['w_br_a']) + jax.nn.sigmoid(g_b) * (y_b @ p['w_br_b'])
         + jax.nn.sigmoid(g_c) * (y_c @ p['w_br_c']))
    return m @ p['w_out']


def token_mixer(h, hc, p, lb_f, lb_b, need_ctx):
    offs = np.cumsum(IN_SPLITS)[:-1].tolist()
    (q, zf, zb, iv, g, hy, qa, kva, kr, ga, gb, gc) = jnp.split(h @ p['w_in'], offs, axis=-1)
    (q_c, zf_c, zb_c, iv_c, g_c, hy_c, qa_c, kva_c, kr_c, ga_c, gb_c, gc_c) = jnp.split(hc @ p['w_in'], offs, axis=-1)
    bsz, L = h.shape[0], h.shape[1]
    Lc = hc.shape[1]

    zero = jnp.zeros((bsz, HG_HEADS, HG_DK, HG_DV), jnp.float32)
    o_ctx, s_f, s_b = hgrn2_seq(q_c, iv_c, zf_c, zb_c, lb_f, lb_b, zero, zero)
    o_lat, _, _ = hgrn2_seq(q, iv, zf, zb, lb_f, lb_b, s_f, s_b)
    y_a = hgrn2_readout(o_lat, g, p['hg_out_norm'])

    y_b = hyena(hy, p, hyena_filters(L, p))

    ang_r, ang_c = axial_angles(L)
    qn, qr = mla_queries(qa, p)
    qr = axial_rope(qr, ang_r[:, None], ang_c[:, None])
    kn, krr, v = mla_keys(kva, kr, p)
    krr = axial_rope(krr, ang_r, ang_c)
    kn_c, krr_c, v_c = mla_keys(kva_c, kr_c, p)
    y_c = latent_attention(qn, qr, kn, krr, v, kn_c, krr_c, v_c)

    out = merge(y_a, y_b, y_c, ga, gb, gc, p)
    if not need_ctx:
        return out, None
    y_a_c = hgrn2_readout(o_ctx, g_c, p['hg_out_norm'])
    y_b_c = hyena(hy_c, p, hyena_filters(Lc, p))
    qn_c, qr_c = mla_queries(qa_c, p)
    y_c_c = mla_attend(qn_c, qr_c, ((kn_c, krr_c, v_c),)).reshape(bsz, Lc, MLA_OUT)
    out_c = merge(y_a_c, y_b_c, y_c_c, ga_c, gb_c, gc_c, p)
    return out, out_c


def half_ffn(y, m, idx, norm, w13, w2):
    return y + 0.5 * m[idx + 2] * swiglu(adaln(y, norm, m[idx], m[idx + 1]), w13, w2)


def layer(x, xc, c, c_ctx, p, lb_f, lb_b, need_ctx):
    mod = jnp.split((jax.nn.silu(c) @ p['ada_w'] + p['ada_b'])[:, None, :], N_MOD, axis=-1)
    mod_c = jnp.split((jax.nn.silu(c_ctx) @ p['ada_w'] + p['ada_b'])[None, None, :], N_MOD, axis=-1)
    x = half_ffn(x, mod, 0, p['ffn1_norm'], p['ffn1_w13'], p['ffn1_w2'])
    xc = half_ffn(xc, mod_c, 0, p['ffn1_norm'], p['ffn1_w13'], p['ffn1_w2'])
    out, out_c = token_mixer(adaln(x, p['mix_norm'], mod[3], mod[4]),
                             adaln(xc, p['mix_norm'], mod_c[3], mod_c[4]), p, lb_f, lb_b, need_ctx)
    x = x + mod[5] * out
    x = half_ffn(x, mod, 6, p['ffn2_norm'], p['ffn2_w13'], p['ffn2_w2'])
    if need_ctx:
        xc = xc + mod_c[5] * out_c
        xc = half_ffn(xc, mod_c, 6, p['ffn2_norm'], p['ffn2_w13'], p['ffn2_w2'])
    return x, xc


def setup_inputs(seed: int = 0) -> dict:
    key = jax.random.key(seed)
    keys = iter(jax.random.split(key, 64))

    def normal(shape, scale=1.0):
        return scale * jax.random.normal(next(keys), shape, jnp.float32)

    def gain(shape):
        return 1.0 + normal(shape, 0.02)

    L, D = DEPTH, D_MODEL
    return {
        'x': normal((BATCH, SEQ, D)),
        'c': normal((BATCH, D)),
        'ctx': normal((BATCH, CTX_LEN, D)),
        'c_ctx': normal((D,)),
        'ada_w': normal((L, D, N_MOD * D), 0.5 * D ** -0.5),
        'ada_b': normal((L, N_MOD * D), 0.02),
        'ffn1_norm': gain((L, D)),
        'ffn1_w13': normal((L, D, 2 * D_FF), D ** -0.5),
        'ffn1_w2': normal((L, D_FF, D), D_FF ** -0.5),
        'mix_norm': gain((L, D)),
        'w_in': normal((L, D, IN_COLS), D ** -0.5),
        'hg_lb_logits': normal((2, L, HG_K), 0.5),
        'hg_out_norm': gain((L, HG_DV)),
        'hy_conv_w': normal((L, 3, 3 * HY_W), 3 ** -0.5),
        'hy_conv_b': normal((L, 3 * HY_W), 0.02),
        'hy_w1': normal((L, HY_EMB, HY_FH), HY_EMB ** -0.5),
        'hy_b1': normal((L, HY_FH), 0.1),
        'hy_w2': normal((L, HY_FH, HY_FH), HY_FH ** -0.5),
        'hy_b2': normal((L, HY_FH), 0.1),
        'hy_w3': normal((L, HY_FH, HY_FH), HY_FH ** -0.5),
        'hy_b3': normal((L, HY_FH), 0.1),
        'hy_w4': normal((L, HY_FH, 2 * HY_ORDER * HY_W), HY_FH ** -0.5),
        'hy_freq': gain((L, HY_FH)),
        'hy_skip': normal((L, HY_ORDER, HY_W), 0.5),
        'q_a_norm': gain((L, MLA_Q_LORA)),
        'w_uq': normal((L, MLA_Q_LORA, MLA_HEADS * MLA_QK), MLA_Q_LORA ** -0.5),
        'kv_a_norm': gain((L, MLA_KV_LORA)),
        'w_ukv': normal((L, MLA_KV_LORA, MLA_HEADS * (MLA_NOPE + MLA_V)), MLA_KV_LORA ** -0.5),
        'q_nope_norm': gain((L, MLA_NOPE)),
        'q_rope_norm': gain((L, MLA_ROPE)),
        'k_nope_norm': gain((L, MLA_NOPE)),
        'k_rope_norm': gain((L, MLA_ROPE)),
        'w_br_a': normal((L, HG_V, D), HG_V ** -0.5),
        'w_br_b': normal((L, HY_W, D), HY_W ** -0.5),
        'w_br_c': normal((L, MLA_OUT, D), MLA_OUT ** -0.5),
        'w_out': normal((L, D, D), D ** -0.5),
        'ffn2_norm': gain((L, D)),
        'ffn2_w13': normal((L, D, 2 * D_FF), D ** -0.5),
        'ffn2_w2': normal((L, D_FF, D), D_FF ** -0.5),
    }


def reference(x, c, ctx, c_ctx, ada_w, ada_b, ffn1_norm, ffn1_w13, ffn1_w2, mix_norm, w_in,
              hg_lb_logits, hg_out_norm, hy_conv_w, hy_conv_b, hy_w1, hy_b1, hy_w2, hy_b2, hy_w3, hy_b3,
              hy_w4, hy_freq, hy_skip, q_a_norm, w_uq, kv_a_norm, w_ukv, q_nope_norm, q_rope_norm,
              k_nope_norm, k_rope_norm, w_br_a, w_br_b, w_br_c, w_out, ffn2_norm, ffn2_w13, ffn2_w2):
    stacked = {
        'ada_w': ada_w, 'ada_b': ada_b, 'ffn1_norm': ffn1_norm, 'ffn1_w13': ffn1_w13, 'ffn1_w2': ffn1_w2,
        'mix_norm': mix_norm, 'w_in': w_in, 'hg_out_norm': hg_out_norm,
        'hy_conv_w': hy_conv_w, 'hy_conv_b': hy_conv_b, 'hy_w1': hy_w1, 'hy_b1': hy_b1, 'hy_w2': hy_w2,
        'hy_b2': hy_b2, 'hy_w3': hy_w3, 'hy_b3': hy_b3, 'hy_w4': hy_w4, 'hy_freq': hy_freq, 'hy_skip': hy_skip,
        'q_a_norm': q_a_norm, 'w_uq': w_uq, 'kv_a_norm': kv_a_norm, 'w_ukv': w_ukv,
        'q_nope_norm': q_nope_norm, 'q_rope_norm': q_rope_norm, 'k_nope_norm': k_nope_norm,
        'k_rope_norm': k_rope_norm, 'w_br_a': w_br_a, 'w_br_b': w_br_b, 'w_br_c': w_br_c, 'w_out': w_out,
        'ffn2_norm': ffn2_norm, 'ffn2_w13': ffn2_w13, 'ffn2_w2': ffn2_w2,
    }
    lbs = jax.nn.softmax(hg_lb_logits.astype(jnp.float32), axis=1)
    lbs = jnp.cumsum(lbs, axis=1) - lbs[:, :1]
    xc = ctx
    for l in range(DEPTH):
        p = {name: val[l] for name, val in stacked.items()}
        x, xc = layer(x, xc, c, c_ctx, p, lbs[0, l], lbs[1, l], l < DEPTH - 1)
    return x
```

```cpp
#include <hip/hip_runtime.h>
#include <hip/hip_cooperative_groups.h>
#include <cstdio>
namespace cg = cooperative_groups;

#define DI __device__ __forceinline__
typedef unsigned short u16;
typedef __attribute__((ext_vector_type(8))) short bf16x8;
typedef __attribute__((ext_vector_type(4))) float f32x4;
typedef __attribute__((ext_vector_type(16))) float f32x16;

constexpr int NTHR = 512;
constexpr int RL = 32768, RA = 33792;
constexpr int LDS_BYTES = 151552;

constexpr size_t OFF_MODS = 0;
constexpr size_t OFF_XC   = OFF_MODS + 368640;
constexpr size_t OFF_HID3 = OFF_XC + 4194304;
constexpr size_t OFF_DEC  = OFF_HID3 + 2162688;
constexpr size_t OFF_TW   = OFF_DEC + 2162688;
constexpr size_t OFF_BAR  = OFF_TW + 65536;
constexpr size_t OFF_WB   = OFF_BAR + 16384;
constexpr size_t OFF_HB   = OFF_WB + 56098816;
constexpr size_t OFF_YA   = OFF_HB + 69206016;
constexpr size_t OFF_YB   = OFF_YA + 34603008;
constexpr size_t OFF_YC   = OFF_YB + 34603008;
constexpr size_t OFF_BIG  = OFF_YC + 34603008;
constexpr size_t BIG_FSCR = 104857600;
constexpr size_t BIG_Q    = 30277632;
constexpr size_t BIG_K    = BIG_Q + 51904512;
constexpr size_t BIG_VT   = BIG_K + 51904512;
constexpr size_t WS_NEED  = OFF_BIG + 207618048;
constexpr int W_13A = 0, W_2A = 5767168, W_IN = 8650752, W_UQ = 16449536, W_UKV = 16646144, W_BRA = 16777216,
              W_BRB = 17301504, W_BRC = 17825792, W_OUT = 18350080, W_13B = 19398656, W_2B = 25165824;

struct Params { const float* in[39]; float* out; unsigned char* ws; };

DI int otid() { int t = __builtin_amdgcn_workitem_id_x(); asm volatile("" : "+v"(t)); return t; }
typedef float f32x2_t __attribute__((ext_vector_type(2)));
typedef __bf16 bf16x2_t __attribute__((ext_vector_type(2)));
DI unsigned pack2(float a, float b) { f32x2_t v = {a, b}; bf16x2_t r = __builtin_convertvector(v, bf16x2_t); return __builtin_bit_cast(unsigned, r); }
DI u16 f2bf(float x) { return (u16)(pack2(x, x) & 0xffffu); }
DI float bf2f(u16 h) { return __uint_as_float(((unsigned)h) << 16); }
DI float blo(unsigned u) { return __uint_as_float(u << 16); }
DI float bhi(unsigned u) { return __uint_as_float(u & 0xffff0000u); }
DI float siluf(float x) { return x / (1.f + __expf(-x)); }
DI float sigmf(float x) { return 1.f / (1.f + __expf(-x)); }
DI float shx(float v, int mask, int lane) { return __int_as_float(__builtin_amdgcn_ds_bpermute((lane ^ mask) << 2, __float_as_int(v))); }
DI float wave_sum(float v, int lane) { for (int o = 32; o > 0; o >>= 1) v += shx(v, o, lane); return v; }
DI float* xrow(const Params& P, int r) { return r < RL ? P.out + (size_t)r * 1024 : (float*)(P.ws + OFF_XC) + (size_t)(r - RL) * 1024; }
DI const float* modp(const Params& P, int l, int r) { int mi = r < RL ? (r >> 13) : 4; return (const float*)(P.ws + OFF_MODS) + (size_t)(l * 5 + mi) * 9216; }
DI float block_sum(float v, float* red) {
  const int t_ = otid();
  v = wave_sum(v, t_ & 63);
  __syncthreads();
  if ((t_ & 63) == 0) red[t_ >> 6] = v;
  __syncthreads();
  float s = 0.f;
  for (int i = 0; i < 8; ++i) s += red[i];
  return s;
}

#define XB_XCNT(j) (256 + 64 * (j))
#define XB_XSUB(j) (1280 + 64 * (j))
#define XB_XGEN(j) (2304 + 64 * (j))
#define XB_TOP 3328
#define XB_TOPGEN 3392
DI unsigned xb_ld(unsigned* p) { return __hip_atomic_load(p, __ATOMIC_RELAXED, __HIP_MEMORY_SCOPE_AGENT); }
DI unsigned xb_add(unsigned* p, unsigned v) { return __hip_atomic_fetch_add(p, v, __ATOMIC_RELAXED, __HIP_MEMORY_SCOPE_AGENT); }
DI unsigned xb_xcc_id() { return (unsigned)__builtin_amdgcn_s_getreg((3 << 11) | 20) & 0xFu; }
struct GBar {
  unsigned* bar; unsigned x, nloc, nx, gen;
  DI void post() { x = xb_xcc_id(); if (__builtin_amdgcn_workitem_id_x() == 0) (void)xb_add(&bar[XB_XCNT(x)], 1u); }
  DI void census() {
    unsigned mine = 0, cnt = 0;
    for (unsigned j = 0; j < 16; ++j) { const unsigned c = xb_ld(&bar[XB_XCNT(j)]); cnt += c > 0u ? 1u : 0u; mine = j == x ? c : mine; }
    nloc = __builtin_amdgcn_readfirstlane(mine > 0u ? mine : 1u); nx = __builtin_amdgcn_readfirstlane(cnt > 0u ? cnt : 1u); gen = 0;
  }
  DI void sync() {
    asm volatile("s_waitcnt vmcnt(0)" ::: "memory");
    __syncthreads();
    if (__builtin_amdgcn_workitem_id_x() == 0) {
      __builtin_amdgcn_s_waitcnt(0);
      const unsigned old = xb_add(&bar[XB_XSUB(x)], 1u);
      if (old + 1u == (gen + 1u) * nloc) {
        __builtin_amdgcn_fence(__ATOMIC_RELEASE, "agent");
        asm volatile("s_waitcnt vmcnt(0)" ::: "memory");
        const unsigned og = xb_add(&bar[XB_TOP], 1u);
        if (og + 1u == (gen + 1u) * nx) xb_add(&bar[XB_TOPGEN], 1u);
        else { while (xb_ld(&bar[XB_TOPGEN]) == gen) __builtin_amdgcn_s_sleep(1); }
        __builtin_amdgcn_fence(__ATOMIC_ACQUIRE, "agent");
        xb_add(&bar[XB_XGEN(x)], 1u);
        asm volatile("s_waitcnt vmcnt(0)" ::: "memory");
      } else {
        while (xb_ld(&bar[XB_XGEN(x)]) == gen) __builtin_amdgcn_s_sleep(1);
        __builtin_amdgcn_fence(__ATOMIC_ACQUIRE, "agent");
        asm volatile("s_waitcnt vmcnt(0)" ::: "memory");
      }
    }
    gen += 1u;
    __syncthreads();
  }
};

DI void mods_phase(const Params& P, unsigned char* smem) {
  float* s = (float*)smem;
  const int tid = otid();
  {
    float2* TW = (float2*)(P.ws + OFF_TW);
    for (int k = blockIdx.x * NTHR + tid; k < 8192; k += gridDim.x * NTHR) {
      float sn, cs;
      sincospif((float)k * (1.f / 8192.f), &sn, &cs);
      TW[k] = float2{cs, -sn};
    }
  }
  for (int it = blockIdx.x; it < 36; it += gridDim.x) {
    const int l = it / 18, n = (it % 18) * 512 + tid;
    __syncthreads();
    for (int i = tid; i < 5120; i += NTHR) { float c = i < 4096 ? P.in[1][i] : P.in[3][i - 4096]; s[i] = siluf(c); }
    __syncthreads();
    float a0 = 0, a1 = 0, a2 = 0, a3 = 0, a4 = 0;
    const float* w = P.in[4] + (size_t)l * 1024 * 9216 + n;
#pragma unroll 8
    for (int k = 0; k < 1024; ++k) {
      float wv = w[(size_t)k * 9216];
      a0 += s[k] * wv; a1 += s[1024 + k] * wv; a2 += s[2048 + k] * wv; a3 += s[3072 + k] * wv; a4 += s[4096 + k] * wv;
    }
    float bb = P.in[5][l * 9216 + n];
    float* m = (float*)(P.ws + OFF_MODS) + (size_t)l * 5 * 9216 + n;
    m[0] = a0 + bb; m[9216] = a1 + bb; m[2 * 9216] = a2 + bb; m[3 * 9216] = a3 + bb; m[4 * 9216] = a4 + bb;
  }
}

DI void hid3_phase(const Params& P, int l, unsigned char* smem) {
  float* emb = (float*)smem;
  float* hA = emb + 64 * 33;
  float* hB = hA + 64 * 65;
  const int tid = otid(), p = tid & 63, fg = tid >> 6;
  const float* w1 = P.in[15] + l * 33 * 64; const float* b1 = P.in[16] + l * 64;
  const float* w2 = P.in[17] + l * 4096;    const float* b2 = P.in[18] + l * 64;
  const float* w3 = P.in[19] + l * 4096;    const float* b3 = P.in[20] + l * 64;
  const float* fr = P.in[22] + l * 64;
  u16* HID = (u16*)(P.ws + OFF_HID3);
  for (int it = blockIdx.x; it < 132; it += gridDim.x) {
    const int L = it < 128 ? 8192 : 256;
    const int pos0 = it < 128 ? it * 64 : (it - 128) * 64;
    u16* outp = HID + (size_t)(it < 128 ? pos0 : 8192 + pos0) * 64;
    __syncthreads();
    for (int e = tid; e < 64 * 33; e += NTHR) {
      int pp = e / 33, j = e % 33;
      float posf = (float)(pos0 + pp);
      float tl = posf / (float)(L - 1);
      float wang = (6.283185307179586f / (float)L) * posf;
      float v;
      if (j == 0) v = tl;
      else {
        int bi = (j - 1) & 15;
        float band = 1e-4f + (float)bi * ((15.f - 1e-4f) / 15.f);
        float ang = band * wang;
        v = (j <= 16) ? cosf(ang) : -sinf(ang);
      }
      emb[pp * 33 + j] = v;
    }
    __syncthreads();
    for (int ff = 0; ff < 8; ++ff) {
      int f = fg * 8 + ff; float a = b1[f];
      for (int j = 0; j < 33; ++j) a += emb[p * 33 + j] * w1[j * 64 + f];
      hA[p * 65 + f] = sinf(fr[f] * a);
    }
    __syncthreads();
    for (int ff = 0; ff < 8; ++ff) {
      int f = fg * 8 + ff; float a = b2[f];
      for (int j = 0; j < 64; ++j) a += hA[p * 65 + j] * w2[j * 64 + f];
      hB[p * 65 + f] = sinf(fr[f] * a);
    }
    __syncthreads();
    for (int ff = 0; ff < 8; ++ff) {
      int f = fg * 8 + ff; float a = b3[f];
      for (int j = 0; j < 64; ++j) a += hB[p * 65 + j] * w3[j * 64 + f];
      outp[p * 64 + f] = f2bf(sinf(fr[f] * a));
    }
  }
}

DI void conv_tile(const float* __restrict__ src, int K, int N, u16* __restrict__ dst, int tile, bool perm13, unsigned char* smem) {
  float* t = (float*)smem;
  const int tid = otid();
  const int ntn = N >> 6;
  const int k0 = (tile / ntn) * 128, n0 = (tile % ntn) * 64;
  __syncthreads();
  {
    const int kk = tid >> 4, nn = (tid & 15) * 4;
    float4 v[4];
#pragma unroll
    for (int it = 0; it < 4; ++it) v[it] = *(const float4*)(src + (size_t)(k0 + kk + 32 * it) * N + n0 + nn);
#pragma unroll
    for (int it = 0; it < 4; ++it) {
      float* d = t + (kk + 32 * it) * 65 + nn;
      d[0] = v[it].x; d[1] = v[it].y; d[2] = v[it].z; d[3] = v[it].w;
    }
  }
  __syncthreads();
  {
    const int nn = tid >> 3, kc = (tid & 7) * 16;
    int n = n0 + nn;
    if (perm13) { n = n < 2816 ? ((n >> 4) * 32 + (n & 15)) : (((n - 2816) >> 4) * 32 + 16 + ((n - 2816) & 15)); }
    unsigned o[8];
#pragma unroll
    for (int j = 0; j < 8; ++j) o[j] = pack2(t[(kc + 2 * j) * 65 + nn], t[(kc + 2 * j + 1) * 65 + nn]);
    u16* dp = dst + (size_t)n * K + k0 + kc;
    *(uint4*)dp = uint4{o[0], o[1], o[2], o[3]};
    *(uint4*)(dp + 8) = uint4{o[4], o[5], o[6], o[7]};
  }
}

DI void convert_phase(const Params& P, int l, unsigned char* smem) {
  u16* WB = (u16*)(P.ws + OFF_WB);
  for (int it = blockIdx.x; it < 3424; it += gridDim.x) {
    int i = it;
    if (i < 704) { conv_tile(P.in[7] + (size_t)l * 1024 * 5632, 1024, 5632, WB + W_13A, i, true, smem); continue; } i -= 704;
    if (i < 352) { conv_tile(P.in[8] + (size_t)l * 2816 * 1024, 2816, 1024, WB + W_2A, i, false, smem); continue; } i -= 352;
    if (i < 952) { conv_tile(P.in[10] + (size_t)l * 1024 * 7616, 1024, 7616, WB + W_IN, i, false, smem); continue; } i -= 952;
    if (i < 24)  { conv_tile(P.in[25] + (size_t)l * 256 * 768, 256, 768, WB + W_UQ, i, false, smem); continue; } i -= 24;
    if (i < 16)  { conv_tile(P.in[27] + (size_t)l * 128 * 1024, 128, 1024, WB + W_UKV, i, false, smem); continue; } i -= 16;
    if (i < 64)  { conv_tile(P.in[32] + (size_t)l * 512 * 1024, 512, 1024, WB + W_BRA, i, false, smem); continue; } i -= 64;
    if (i < 64)  { conv_tile(P.in[33] + (size_t)l * 512 * 1024, 512, 1024, WB + W_BRB, i, false, smem); continue; } i -= 64;
    if (i < 64)  { conv_tile(P.in[34] + (size_t)l * 512 * 1024, 512, 1024, WB + W_BRC, i, false, smem); continue; } i -= 64;
    if (i < 128) { conv_tile(P.in[35] + (size_t)l * 1024 * 1024, 1024, 1024, WB + W_OUT, i, false, smem); continue; } i -= 128;
    if (i < 704) { conv_tile(P.in[37] + (size_t)l * 1024 * 5632, 1024, 5632, WB + W_13B, i, true, smem); continue; } i -= 704;
    conv_tile(P.in[38] + (size_t)l * 2816 * 1024, 2816, 1024, WB + W_2B, i, false, smem);
  }
}

DI void norm_phase(const Params& P, int l, int which, int nrows, bool first) {
  const int tid_ = otid(), lane = tid_ & 63, w = tid_ >> 6;
  const float* gw = (which == 0 ? P.in[6] : which == 1 ? P.in[9] : P.in[36]) + l * 1024;
  u16* HB = (u16*)(P.ws + OFF_HB);
  for (int row = blockIdx.x * 8 + w; row < nrows; row += gridDim.x * 8) {
    float* xr = xrow(P, row);
    const float* src = first ? (row < RL ? P.in[0] + (size_t)row * 1024 : P.in[2] + (size_t)(row - RL) * 1024) : xr;
    float4 v[4];
    float ss = 0.f;
    for (int j = 0; j < 4; ++j) {
      v[j] = ((const float4*)src)[j * 64 + lane];
      ss += v[j].x * v[j].x + v[j].y * v[j].y + v[j].z * v[j].z + v[j].w * v[j].w;
    }
    ss = wave_sum(ss, lane);
    float rstd = rsqrtf(ss * (1.f / 1024.f) + 1e-6f);
    const float* md = modp(P, l, row) + which * 3 * 1024;
    for (int j = 0; j < 4; ++j) {
      if (first) ((float4*)xr)[j * 64 + lane] = v[j];
      int col = (j * 64 + lane) * 4;
      float4 g = *(const float4*)(gw + col);
      float4 sh = *(const float4*)(md + col);
      float4 sc = *(const float4*)(md + 1024 + col);
      uint2 o;
      o.x = pack2(v[j].x * rstd * g.x * (1.f + sc.x) + sh.x, v[j].y * rstd * g.y * (1.f + sc.y) + sh.y);
      o.y = pack2(v[j].z * rstd * g.z * (1.f + sc.z) + sh.z, v[j].w * rstd * g.w * (1.f + sc.w) + sh.w);
      *(uint2*)(HB + (size_t)row * 1024 + col) = o;
    }
  }
}

#define LDSP(p) ((__attribute__((address_space(3))) unsigned*)(p))
#define GLBP(p) ((__attribute__((address_space(1))) const unsigned*)(p))
#define WAIT_VM(n) asm volatile("s_waitcnt vmcnt(" #n ")" ::: "memory")
#define RAW_BARRIER() do { asm volatile("s_waitcnt lgkmcnt(0)" ::: "memory"); __builtin_amdgcn_s_barrier(); asm volatile("" ::: "memory"); } while (0)

template <bool SWAP = false>
DI void gemm_main(f32x4 (&acc)[4][4], const u16* __restrict__ Act, int lda, const u16* __restrict__ Wt, int ldw, int K,
                  int row0, int col0, unsigned char* smem) {
  const int tid = otid(), lane = tid & 63, w = tid >> 6, wt = w & 3, wc = w >> 2;
  const int lr = tid >> 3, lc = (tid & 7) ^ ((lr >> 1) & 7);
  const u16* srcA = Act + (size_t)(row0 + lr) * lda + lc * 8;
  const u16* srcW = Wt + (size_t)(col0 + lr) * ldw + lc * 8;
  const int nk = K >> 6;
  const int fr = lane & 15, fq = lane >> 4, key = (fr >> 1) & 7;
  unsigned char* wbase = smem + w * 1024;
#define GM_DMA(KT, ST) do { const int k0_ = (KT) * 64; unsigned char* d_ = wbase + (ST) * 49152; \
    __builtin_amdgcn_global_load_lds(GLBP(srcA + k0_), LDSP(d_), 16, 0, 0); \
    __builtin_amdgcn_global_load_lds(GLBP(srcA + (size_t)64 * lda + k0_), LDSP(d_ + 8192), 16, 0, 0); \
    __builtin_amdgcn_global_load_lds(GLBP(srcA + (size_t)128 * lda + k0_), LDSP(d_ + 16384), 16, 0, 0); \
    __builtin_amdgcn_global_load_lds(GLBP(srcA + (size_t)192 * lda + k0_), LDSP(d_ + 24576), 16, 0, 0); \
    __builtin_amdgcn_global_load_lds(GLBP(srcW + k0_), LDSP(d_ + 32768), 16, 0, 0); \
    __builtin_amdgcn_global_load_lds(GLBP(srcW + (size_t)64 * ldw + k0_), LDSP(d_ + 40960), 16, 0, 0); } while (0)
#define GM_FRAGS(A_, B_, ST, KS) do { const unsigned char* base_ = smem + (ST) * 49152; const int po_ = (((KS) * 4 + fq) ^ key) * 16; \
    _Pragma("unroll") for (int ct = 0; ct < 4; ++ct) A_[ct] = *(const bf16x8*)(base_ + (256 + wc * 64 + ct * 16 + fr) * 128 + po_); \
    _Pragma("unroll") for (int tt = 0; tt < 4; ++tt) B_[tt] = *(const bf16x8*)(base_ + (wt * 64 + tt * 16 + fr) * 128 + po_); } while (0)
#define GM_MMA(A_, B_) do { \
    _Pragma("unroll") for (int ct = 0; ct < 4; ++ct) \
      _Pragma("unroll") for (int tt = 0; tt < 4; ++tt) \
        acc[ct][tt] = SWAP ? __builtin_amdgcn_mfma_f32_16x16x32_bf16(B_[tt], A_[ct], acc[ct][tt], 0, 0, 0) \
                           : __builtin_amdgcn_mfma_f32_16x16x32_bf16(A_[ct], B_[tt], acc[ct][tt], 0, 0, 0); } while (0)
  bf16x8 fa0[4], fb0[4], fa1[4], fb1[4];
  WAIT_VM(0);
  RAW_BARRIER();
  GM_DMA(0, 0);
  if (nk > 1) GM_DMA(1, 1);
  if (nk > 2) GM_DMA(2, 2);
  if (nk > 2) WAIT_VM(12); else if (nk > 1) WAIT_VM(6); else WAIT_VM(0);
  RAW_BARRIER();
  GM_FRAGS(fa0, fb0, 0, 0);
  int st = 0;
  for (int kt = 0; kt < nk; ++kt) {
    const int st1 = st == 2 ? 0 : st + 1;
    GM_FRAGS(fa1, fb1, st, 1);
    GM_MMA(fa0, fb0);
    if (kt + 1 < nk) {
      if (kt + 2 < nk) WAIT_VM(6); else WAIT_VM(0);
      RAW_BARRIER();
      if (kt + 3 < nk) GM_DMA(kt + 3, st);
      GM_FRAGS(fa0, fb0, st1, 0);
    }
    GM_MMA(fa1, fb1);
    st = st1;
  }
#undef GM_FRAGS
#undef GM_MMA
#undef GM_DMA
}

DI void zero_acc(f32x4 (&acc)[4][4]) {
#pragma unroll
  for (int a = 0; a < 4; ++a)
#pragma unroll
    for (int b = 0; b < 4; ++b) acc[a][b] = f32x4{0.f, 0.f, 0.f, 0.f};
}

struct TileIter {
  int ntn, nmain_it, ntot_it, x, slot, nslot, rem0;
  DI TileIter(int ntm, int ntn_) {
    ntn = ntn_;
    x = blockIdx.x & 7; slot = blockIdx.x >> 3; nslot = gridDim.x >> 3;
    const int nmain = (ntm >> 3) * ntn;
    rem0 = (ntm >> 3) << 3;
    const int nrem = (ntm - rem0) * ntn;
    nmain_it = slot < nmain ? (nmain - slot + nslot - 1) / nslot : 0;
    const int nrem_it = (int)blockIdx.x < nrem ? (nrem - (int)blockIdx.x + (int)gridDim.x - 1) / (int)gridDim.x : 0;
    ntot_it = nmain_it + nrem_it;
  }
  DI void get(int i, int& rt, int& ct) const {
    if (i < nmain_it) { const int q = slot + i * nslot; rt = (q / ntn) * 8 + x; ct = q % ntn; }
    else { const int j = blockIdx.x + (i - nmain_it) * gridDim.x; rt = rem0 + j / ntn; ct = j % ntn; }
  }
};

template <bool SWAP = false, class Epi>
DI void gemm_phase(const u16* Act, int lda, const u16* Wt, int ldw, int K, int Mrows, int Ncols, unsigned char* smem, Epi epi,
                   int ct_mul = 1, int ct_off = 0) {
  const int ntn = (Ncols + 127) >> 7, ntm = Mrows >> 8;
  const int tid_ = otid(), lane = tid_ & 63, w = tid_ >> 6, wt = w & 3, wc = w >> 2;
  const TileIter ti(ntm, ntn);
  for (int i = 0; i < ti.ntot_it; ++i) {
    int rt_, ct_;
    ti.get(i, rt_, ct_);
    const int row0 = rt_ * 256, col0 = (ct_ * ct_mul + ct_off) * 128;
    f32x4 acc[4][4];
    zero_acc(acc);
    gemm_main<SWAP>(acc, Act, lda, Wt, ldw, K, row0, col0, smem);
    const int rbase = row0 + wt * 64 + (SWAP ? (lane >> 4) * 4 : (lane & 15));
    const int cbase = col0 + wc * 64 + (SWAP ? (lane & 15) : (lane >> 4) * 4);
    epi(acc, rbase, cbase);
  }
}

DI void gemm_main2(f32x4 (&acc)[8][4], const u16* __restrict__ Act, int lda, const u16* __restrict__ Wt, int ldw, int K,
                   int row0, int col0, unsigned char* smem) {
  const int tid = otid(), lane = tid & 63, w = tid >> 6, wt = w & 3, wc = w >> 2;
  const int lr = tid >> 2, lc = (tid & 3) ^ ((lr >> 2) & 3);
  const u16* srcA = Act + (size_t)(row0 + lr) * lda + lc * 8;
  const u16* srcW = Wt + (size_t)(col0 + lr) * ldw + lc * 8;
  const int nk = K >> 5;
  const int fr = lane & 15, fq = lane >> 4;
  const int po = (fq ^ ((fr >> 2) & 3)) * 16;
  unsigned char* wbase = smem + w * 1024;
#define G2_DMA(KT, ST) do { const int k0_ = (KT) * 32; unsigned char* d_ = wbase + (ST) * 32768; \
    __builtin_amdgcn_global_load_lds(GLBP(srcA + k0_), LDSP(d_), 16, 0, 0); \
    __builtin_amdgcn_global_load_lds(GLBP(srcA + (size_t)128 * lda + k0_), LDSP(d_ + 8192), 16, 0, 0); \
    __builtin_amdgcn_global_load_lds(GLBP(srcW + k0_), LDSP(d_ + 16384), 16, 0, 0); \
    __builtin_amdgcn_global_load_lds(GLBP(srcW + (size_t)128 * ldw + k0_), LDSP(d_ + 24576), 16, 0, 0); } while (0)
  WAIT_VM(0);
  RAW_BARRIER();
  G2_DMA(0, 0);
  if (nk > 1) G2_DMA(1, 1);
  int st = 0;
  for (int kt = 0; kt < nk; ++kt) {
    if (kt + 1 < nk) WAIT_VM(4); else WAIT_VM(0);
    RAW_BARRIER();
    if (kt + 2 < nk) { const int s2 = st >= 1 ? st - 1 : 2; G2_DMA(kt + 2, s2); }
    const unsigned char* base = smem + st * 32768;
    __builtin_amdgcn_iglp_opt(1);
    bf16x8 a[8], b[4];
#pragma unroll
    for (int ct = 0; ct < 8; ++ct) a[ct] = *(const bf16x8*)(base + (256 + wc * 128 + ct * 16 + fr) * 64 + po);
#pragma unroll
    for (int tt = 0; tt < 4; ++tt) b[tt] = *(const bf16x8*)(base + (wt * 64 + tt * 16 + fr) * 64 + po);
#pragma unroll
    for (int ct = 0; ct < 8; ++ct)
#pragma unroll
      for (int tt = 0; tt < 4; ++tt) acc[ct][tt] = __builtin_amdgcn_mfma_f32_16x16x32_bf16(a[ct], b[tt], acc[ct][tt], 0, 0, 0);
    st = st == 2 ? 0 : st + 1;
  }
#undef G2_DMA
}

template <class Epi>
DI void gemm_phase2(const u16* Act, int lda, const u16* Wt, int ldw, int K, int Mrows, int Ncols, unsigned char* smem, Epi epi) {
  const int ntn = Ncols >> 8, ntm = Mrows >> 8;
  const int tid_ = otid(), lane = tid_ & 63, w = tid_ >> 6, wt = w & 3, wc = w >> 2;
  const TileIter ti(ntm, ntn);
  for (int i = 0; i < ti.ntot_it; ++i) {
    int rt_, ct_;
    ti.get(i, rt_, ct_);
    const int row0 = rt_ * 256, col0 = ct_ * 256;
    f32x4 acc[8][4];
#pragma unroll
    for (int a = 0; a < 8; ++a)
#pragma unroll
      for (int b = 0; b < 4; ++b) acc[a][b] = f32x4{0.f, 0.f, 0.f, 0.f};
    gemm_main2(acc, Act, lda, Wt, ldw, K, row0, col0, smem);
    epi(acc, row0 + wt * 64 + (lane & 15), col0 + wc * 128 + (lane >> 4) * 4);
  }
}

DI float lb_value(const Params& P, int dir, int l, int k) {
  if (l == 0) return 0.f;
  float a = P.in[11][(dir * 2 + 0) * 512 + k], b = P.in[11][(dir * 2 + 1) * 512 + k];
  float m = fmaxf(a, b);
  float ea = __expf(a - m), eb = __expf(b - m);
  return eb / (ea + eb);
}

DI void hgrn_h1(const Params& P, int l, unsigned char* smem) {
  u16* PA = (u16*)(P.ws + OFF_BIG);
  u16* YA = (u16*)(P.ws + OFF_YA);
  u16* OF = (u16*)(P.ws + OFF_YB);
  u16* OB = (u16*)(P.ws + OFF_YC);
  float* DEC = (float*)(P.ws + OFF_DEC);
  u16* sQF = (u16*)smem;
  u16* sKF = sQF + 64 * 136;
  u16* sQB = sKF + 64 * 136;
  u16* sKB = sQB + 64 * 136;
  u16* sVT = sKB + 64 * 136;
  u16* sAT = sVT + 128 * 72;
  float* ps = (float*)(sAT + 2 * 64 * 72);
  const int tid = otid(), lane = tid & 63, w = tid >> 6;
  const int d = tid & 127, sq = tid >> 7;
  for (int it = blockIdx.x; it < 528 * 4; it += gridDim.x) {
    const int ch = it >> 2, h = it & 3;
    const int row0 = ch * 64;
    const float lbf = lb_value(P, 0, l, h * 128 + d), lbb = lb_value(P, 1, l, h * 128 + d);
    float gf[16], gb[16], kf[16], kb[16], qs[16];
    u16 vv[16];
    float pf = 0.f, pb = 0.f;
    {
      const u16* src = PA + (size_t)(row0 + sq * 16) * 2560 + h * 128 + d;
#pragma unroll
      for (int j = 0; j < 16; ++j) {
        float q = bf2f(src[(size_t)j * 2560]);
        float zf = bf2f(src[(size_t)j * 2560 + 512]);
        float zb = bf2f(src[(size_t)j * 2560 + 1024]);
        vv[j] = src[(size_t)j * 2560 + 1536];
        qs[j] = siluf(q) * 0.08838834764831845f;
        float sf = sigmf(zf), sb = sigmf(zb);
        float ff = lbf + (1.f - lbf) * sf, fb = lbb + (1.f - lbb) * sb;
        gf[j] = __logf(ff); gb[j] = __logf(fb);
        kf[j] = (1.f - lbf) * (1.f - sf); kb[j] = (1.f - lbb) * (1.f - sb);
        pf += gf[j]; pb += gb[j];
      }
    }
    asm volatile("s_waitcnt vmcnt(0)" ::: "memory");
    __syncthreads();
    ps[(0 * 4 + sq) * 128 + d] = pf;
    ps[(1 * 4 + sq) * 128 + d] = pb;
    __syncthreads();
    float offf = 0.f, totf = 0.f, offb = 0.f, totb = 0.f;
#pragma unroll
    for (int s2 = 0; s2 < 4; ++s2) {
      float a = ps[s2 * 128 + d], b = ps[(4 + s2) * 128 + d];
      totf += a; totb += b;
      if (s2 < sq) offf += a;
      if (s2 > sq) offb += b;
    }
    if (sq == 0) {
      DEC[((size_t)(0 * 528 + ch) * 4 + h) * 128 + d] = __expf(totf);
      DEC[((size_t)(1 * 528 + ch) * 4 + h) * 128 + d] = __expf(totb);
    }
    {
      unsigned kh[8];
      float bc = offf;
#pragma unroll
      for (int j = 0; j < 16; ++j) {
        bc += gf[j];
        const int s = sq * 16 + j;
        u16 qt = f2bf(qs[j] * __expf(bc));
        sQF[s * 136 + d] = qt;
        sKF[s * 136 + d] = f2bf(kf[j] * __expf(fminf(-bc, 80.f)));
        PA[(size_t)(row0 + s) * 2560 + h * 128 + d] = qt;
        u16 khv = f2bf(kf[j] * __expf(totf - bc));
        if (j & 1) kh[j >> 1] |= ((unsigned)khv) << 16; else kh[j >> 1] = khv;
      }
      u16* dst = PA + (size_t)(row0 + (d >> 1)) * 2560 + 512 + h * 128 + (d & 1) * 64 + sq * 16;
      *(uint4*)dst = uint4{kh[0], kh[1], kh[2], kh[3]};
      *(uint4*)(dst + 8) = uint4{kh[4], kh[5], kh[6], kh[7]};
    }
    {
      unsigned kh[8];
      float bc = offb;
#pragma unroll
      for (int j = 15; j >= 0; --j) {
        bc += gb[j];
        const int s = sq * 16 + j;
        u16 qt = f2bf(qs[j] * __expf(bc));
        sQB[s * 136 + d] = qt;
        sKB[s * 136 + d] = f2bf(kb[j] * __expf(fminf(-bc, 80.f)));
        YA[(size_t)(row0 + s) * 512 + h * 128 + d] = qt;
        u16 khv = f2bf(kb[j] * __expf(totb - bc));
        if (j & 1) kh[j >> 1] = ((unsigned)khv) << 16; else kh[j >> 1] |= khv;
      }
      u16* dst = PA + (size_t)(row0 + (d >> 1)) * 2560 + 1024 + h * 128 + (d & 1) * 64 + sq * 16;
      *(uint4*)dst = uint4{kh[0], kh[1], kh[2], kh[3]};
      *(uint4*)(dst + 8) = uint4{kh[4], kh[5], kh[6], kh[7]};
    }
    {
      unsigned vp[8];
#pragma unroll
      for (int j = 0; j < 8; ++j) vp[j] = (unsigned)vv[2 * j] | ((unsigned)vv[2 * j + 1] << 16);
      u16* dst = PA + (size_t)(row0 + (d >> 1)) * 2560 + 1536 + h * 128 + (d & 1) * 64 + sq * 16;
      *(uint4*)dst = uint4{vp[0], vp[1], vp[2], vp[3]};
      *(uint4*)(dst + 8) = uint4{vp[4], vp[5], vp[6], vp[7]};
      u16* ld = sVT + d * 72 + sq * 16;
      *(uint4*)ld = uint4{vp[0], vp[1], vp[2], vp[3]};
      *(uint4*)(ld + 8) = uint4{vp[4], vp[5], vp[6], vp[7]};
    }
    __syncthreads();
    {
      const int dir = w >> 2, tt = w & 3;
      const u16* sQ = dir ? sQB : sQF;
      const u16* sK = dir ? sKB : sKF;
      const int fr = lane & 15, fq = lane >> 4;
      bf16x8 a[4];
#pragma unroll
      for (int ks = 0; ks < 4; ++ks) a[ks] = *(const bf16x8*)(sQ + (tt * 16 + fr) * 136 + ks * 32 + fq * 8);
#pragma unroll
      for (int st = 0; st < 4; ++st) {
        f32x4 c = {0.f, 0.f, 0.f, 0.f};
#pragma unroll
        for (int ks = 0; ks < 4; ++ks) {
          bf16x8 b = *(const bf16x8*)(sK + (st * 16 + fr) * 136 + ks * 32 + fq * 8);
          c = __builtin_amdgcn_mfma_f32_16x16x32_bf16(a[ks], b, c, 0, 0, 0);
        }
        const int s = st * 16 + fr;
#pragma unroll
        for (int i = 0; i < 4; ++i) {
          const int t = tt * 16 + fq * 4 + i;
          bool keep = dir ? (s >= t) : (s <= t);
          sAT[(dir * 64 + t) * 72 + s] = keep ? f2bf(c[i]) : (u16)0;
        }
      }
    }
    __syncthreads();
    {
      const int dir = w >> 2;
      const int fr = lane & 15, fq = lane >> 4;
      u16* OX = dir ? OB : OF;
#pragma unroll
      for (int mi = 0; mi < 2; ++mi) {
        const int mt = (w & 3) * 2 + mi;
        bf16x8 a0 = *(const bf16x8*)(sVT + (mt * 16 + fr) * 72 + fq * 8);
        bf16x8 a1 = *(const bf16x8*)(sVT + (mt * 16 + fr) * 72 + 32 + fq * 8);
#pragma unroll
        for (int nt = 0; nt < 4; ++nt) {
          bf16x8 b0 = *(const bf16x8*)(sAT + (dir * 64 + nt * 16 + fr) * 72 + fq * 8);
          bf16x8 b1 = *(const bf16x8*)(sAT + (dir * 64 + nt * 16 + fr) * 72 + 32 + fq * 8);
          f32x4 c = {0.f, 0.f, 0.f, 0.f};
          c = __builtin_amdgcn_mfma_f32_16x16x32_bf16(a0, b0, c, 0, 0, 0);
          c = __builtin_amdgcn_mfma_f32_16x16x32_bf16(a1, b1, c, 0, 0, 0);
          const int t = nt * 16 + fr, dv = mt * 16 + fq * 4;
          *(uint2*)(OX + (size_t)(row0 + t) * 512 + h * 128 + dv) = uint2{pack2(c[0], c[1]), pack2(c[2], c[3])};
        }
      }
    }
  }
}

struct H2Regs { uint4 qf[4]; uint2 oold; uint4 kt[2]; uint4 vt[2]; float4 dec; };

DI void hgrn_h2(const Params& P, unsigned char* smem) {
  const u16* PA = (const u16*)(P.ws + OFF_BIG);
  const u16* YA = (const u16*)(P.ws + OFF_YA);
  const float* DEC = (const float*)(P.ws + OFF_DEC);
  u16* sS = (u16*)smem;
  const int tid = otid(), lane = tid & 63, w = tid >> 6, fr = lane & 15, fq = lane >> 4;
  for (int it = blockIdx.x; it < 256; it += gridDim.x) {
    const int ds = it & 7, dir = (it >> 3) & 1, h = (it >> 4) & 3, b = it >> 6;
    u16* OX = (u16*)(P.ws + (dir ? OFF_YC : OFF_YB));
    __syncthreads();
    for (int i = tid; i < 16 * 136; i += NTHR) sS[i] = 0;
    f32x4 S = {0.f, 0.f, 0.f, 0.f};
    auto chunk_of = [&](int step) -> int {
      if (step < 4) return 512 + b * 4 + (dir ? 3 - step : step);
      int c = step - 4;
      return b * 128 + (dir ? 127 - c : c);
    };
    auto load = [&](int step, H2Regs& r) {
      const int ch = chunk_of(step), row0 = ch * 64;
      if (w < 4) {
        const int t = w * 16 + fr;
        const u16* qsrc = dir ? (YA + (size_t)(row0 + t) * 512 + h * 128) : (PA + (size_t)(row0 + t) * 2560 + h * 128);
#pragma unroll
        for (int ks = 0; ks < 4; ++ks) r.qf[ks] = *(const uint4*)(qsrc + ks * 32 + fq * 8);
        r.oold = *(const uint2*)(OX + (size_t)(row0 + t) * 512 + h * 128 + ds * 16 + fq * 4);
      }
      const int dd = w * 16 + fr;
      const u16* ksrc = PA + (size_t)(row0 + (dd >> 1)) * 2560 + (dir ? 1024 : 512) + h * 128 + (dd & 1) * 64;
      const int dv = ds * 16 + fr;
      const u16* vsrc = PA + (size_t)(row0 + (dv >> 1)) * 2560 + 1536 + h * 128 + (dv & 1) * 64;
#pragma unroll
      for (int ks = 0; ks < 2; ++ks) {
        r.kt[ks] = *(const uint4*)(ksrc + ks * 32 + fq * 8);
        r.vt[ks] = *(const uint4*)(vsrc + ks * 32 + fq * 8);
      }
      r.dec = *(const float4*)(DEC + ((size_t)(dir * 528 + ch) * 4 + h) * 128 + w * 16 + fq * 4);
    };
    H2Regs cur, nxt;
    load(0, cur);
    __syncthreads();
    for (int step = 0; step < 132; ++step) {
      if (step + 1 < 132) load(step + 1, nxt);
      const int row0 = chunk_of(step) * 64;
      if (w < 4) {
        f32x4 c = {0.f, 0.f, 0.f, 0.f};
#pragma unroll
        for (int ks = 0; ks < 4; ++ks) {
          bf16x8 a = *(const bf16x8*)(sS + fr * 136 + ks * 32 + fq * 8);
          c = __builtin_amdgcn_mfma_f32_16x16x32_bf16(a, __builtin_bit_cast(bf16x8, cur.qf[ks]), c, 0, 0, 0);
        }
        const int t = w * 16 + fr;
        uint2 o;
        o.x = pack2(blo(cur.oold.x) + c[0], bhi(cur.oold.x) + c[1]);
        o.y = pack2(blo(cur.oold.y) + c[2], bhi(cur.oold.y) + c[3]);
        *(uint2*)(OX + (size_t)(row0 + t) * 512 + h * 128 + ds * 16 + fq * 4) = o;
      }
      S[0] *= cur.dec.x; S[1] *= cur.dec.y; S[2] *= cur.dec.z; S[3] *= cur.dec.w;
#pragma unroll
      for (int ks = 0; ks < 2; ++ks)
        S = __builtin_amdgcn_mfma_f32_16x16x32_bf16(__builtin_bit_cast(bf16x8, cur.kt[ks]), __builtin_bit_cast(bf16x8, cur.vt[ks]), S, 0, 0, 0);
      __syncthreads();
      *(uint2*)(sS + fr * 136 + w * 16 + fq * 4) = uint2{pack2(S[0], S[1]), pack2(S[2], S[3])};
      __syncthreads();
      cur = nxt;
    }
  }
}

DI void hgrn_h3(const Params& P, int l, int nrows) {
  const u16* PA = (const u16*)(P.ws + OFF_BIG);
  const u16* OF = (const u16*)(P.ws + OFF_YB);
  const u16* OB = (const u16*)(P.ws + OFF_YC);
  u16* YA = (u16*)(P.ws + OFF_YA);
  const int tid_ = otid(), lane = tid_ & 63, w = tid_ >> 6;
  const float* gain = P.in[12] + l * 128;
  for (int row = blockIdx.x * 8 + w; row < nrows; row += gridDim.x * 8) {
    uint4 a = *(const uint4*)(OF + (size_t)row * 512 + lane * 8);
    uint4 b = *(const uint4*)(OB + (size_t)row * 512 + lane * 8);
    uint4 g = *(const uint4*)(PA + (size_t)row * 2560 + 2048 + lane * 8);
    float o[8] = {blo(a.x) + blo(b.x), bhi(a.x) + bhi(b.x), blo(a.y) + blo(b.y), bhi(a.y) + bhi(b.y),
                  blo(a.z) + blo(b.z), bhi(a.z) + bhi(b.z), blo(a.w) + blo(b.w), bhi(a.w) + bhi(b.w)};
    float gg[8] = {blo(g.x), bhi(g.x), blo(g.y), bhi(g.y), blo(g.z), bhi(g.z), blo(g.w), bhi(g.w)};
    float ss = 0.f;
    for (int j = 0; j < 8; ++j) ss += o[j] * o[j];
    for (int m = 1; m < 16; m <<= 1) ss += shx(ss, m, lane);
    float rstd = rsqrtf(ss * (1.f / 128.f) + 1e-6f);
    const int dv0 = (lane & 15) * 8;
    float y[8];
    for (int j = 0; j < 8; ++j) y[j] = o[j] * rstd * gain[dv0 + j] * siluf(gg[j]);
    *(uint4*)(YA + (size_t)row * 512 + lane * 8) = uint4{pack2(y[0], y[1]), pack2(y[2], y[3]), pack2(y[4], y[5]), pack2(y[6], y[7])};
  }
}

DI float2 cmul(float2 a, float2 b) { return float2{a.x * b.x - a.y * b.y, a.x * b.y + a.y * b.x}; }

DI float2 twd(const float2* TQ, int k) {
  const bool lowq = k <= 2048;
  const float2 e = TQ[lowq ? k : 4096 - k];
  return lowq ? float2{e.x, -e.y} : float2{e.y, -e.x};
}

DI int ph(int i) { return i + (i >> 7); }

DI void bfly_fwd(float2& a0, float2& a1, float2& a2, float2& a3, float2 w1) {
  float2 w2 = cmul(w1, w1);
  float2 b0 = {a0.x + a2.x, a0.y + a2.y};
  float2 b2 = cmul(float2{a0.x - a2.x, a0.y - a2.y}, w1);
  float2 b1 = {a1.x + a3.x, a1.y + a3.y};
  float2 d3 = {a1.x - a3.x, a1.y - a3.y};
  float2 b3 = cmul(float2{d3.y, -d3.x}, w1);
  a0 = float2{b0.x + b1.x, b0.y + b1.y};
  a1 = cmul(float2{b0.x - b1.x, b0.y - b1.y}, w2);
  a2 = float2{b2.x + b3.x, b2.y + b3.y};
  a3 = cmul(float2{b2.x - b3.x, b2.y - b3.y}, w2);
}
DI void bfly_inv(float2& a0, float2& a1, float2& a2, float2& a3, float2 w1) {
  float2 w2 = cmul(w1, w1);
  float2 t = cmul(a1, w2);
  float2 b0 = {a0.x + t.x, a0.y + t.y}, b1 = {a0.x - t.x, a0.y - t.y};
  t = cmul(a3, w2);
  float2 b2 = {a2.x + t.x, a2.y + t.y}, b3 = {a2.x - t.x, a2.y - t.y};
  t = cmul(b2, w1);
  a0 = float2{b0.x + t.x, b0.y + t.y};
  a2 = float2{b0.x - t.x, b0.y - t.y};
  float2 u = cmul(b3, w1);
  t = float2{-u.y, u.x};
  a1 = float2{b1.x + t.x, b1.y + t.y};
  a3 = float2{b1.x - t.x, b1.y - t.y};
}

template <bool INV, int LH>
DI void fft_pass(float2* X, const float2* __restrict__ TW, int tid) {
  constexpr int h = 1 << LH, hh = h >> 1;
  asm volatile("" : "+v"(tid));
  int p0[8], lo[8];
  float2 a0[8], a1[8], a2[8], a3[8], w1[8];
#pragma unroll
  for (int k = 0; k < 8; ++k) {
    const int q = tid + k * NTHR;
    if (LH >= 7) {
      lo[k] = q & (hh - 1);
      const int hi = q >> (LH - 1);
      p0[k] = (hi << (LH + 1)) + lo[k];
    } else {
      const int r = q & 127, bidx = q >> 7;
      lo[k] = bidx & (hh - 1);
      const int hi = bidx >> (LH - 1);
      p0[k] = r * 129 + (hi << (LH + 1)) + lo[k];
    }
    w1[k] = twd(TW, lo[k] << (13 - LH));
  }
#pragma unroll
  for (int k = 0; k < 8; ++k) {
    if (LH >= 7) {
      const int i0 = p0[k];
      a0[k] = X[ph(i0)]; a1[k] = X[ph(i0 + hh)]; a2[k] = X[ph(i0 + h)]; a3[k] = X[ph(i0 + h + hh)];
    } else {
      a0[k] = X[p0[k]]; a1[k] = X[p0[k] + hh]; a2[k] = X[p0[k] + h]; a3[k] = X[p0[k] + h + hh];
    }
  }
#pragma unroll
  for (int k = 0; k < 8; ++k) {
    float2 w = w1[k];
    if (INV) { w.y = -w.y; bfly_inv(a0[k], a1[k], a2[k], a3[k], w); }
    else bfly_fwd(a0[k], a1[k], a2[k], a3[k], w);
    if (LH >= 7) {
      const int i0 = p0[k];
      X[ph(i0)] = a0[k]; X[ph(i0 + hh)] = a1[k]; X[ph(i0 + h)] = a2[k]; X[ph(i0 + h + hh)] = a3[k];
    } else {
      X[p0[k]] = a0[k]; X[p0[k] + hh] = a1[k]; X[p0[k] + h] = a2[k]; X[p0[k] + h + hh] = a3[k];
    }
  }
  __syncthreads();
}

DI void fft_fwd(float2* X, const float2* __restrict__ TW) {
  const int tid = otid();
  fft_pass<false, 13>(X, TW, tid); fft_pass<false, 11>(X, TW, tid); fft_pass<false, 9>(X, TW, tid); fft_pass<false, 7>(X, TW, tid);
  fft_pass<false, 5>(X, TW, tid); fft_pass<false, 3>(X, TW, tid); fft_pass<false, 1>(X, TW, tid);
}
DI void fft_inv(float2* X, const float2* __restrict__ TW) {
  const int tid = otid();
  fft_pass<true, 1>(X, TW, tid); fft_pass<true, 3>(X, TW, tid); fft_pass<true, 5>(X, TW, tid); fft_pass<true, 7>(X, TW, tid);
  fft_pass<true, 9>(X, TW, tid); fft_pass<true, 11>(X, TW, tid); fft_pass<true, 13>(X, TW, tid);
}

DI float hy_delta(int c) {
  const float mn = -3.0701134573253945f, mx = -15.350567286626973f;
  return fabsf(mn + (mx - mn) * ((float)c / 511.f));
}

DI float conv3_at(const u16* seq, int t, int L, float w0, float w1, float w2, float bias) {
  float c = bf2f(seq[t]);
  float a = t > 0 ? bf2f(seq[t - 1]) : 0.f;
  float b = t < L - 1 ? bf2f(seq[t + 1]) : 0.f;
  return a * w0 + c * w1 + b * w2 + bias;
}

DI void hyena_phase(const Params& P, int l, unsigned char* smem) {
  float2* X = (float2*)smem;
  float* ex = (float*)(smem + 132096);
  const u16* PB = (const u16*)(P.ws + OFF_BIG);
  u16* YB = (u16*)(P.ws + OFF_YB);
  const u16* HID = (const u16*)(P.ws + OFF_HID3);
  const float2* TWG = (const float2*)(P.ws + OFF_TW);
  float2* TWL = (float2*)(smem + 134144);
  const float2* TW = TWL;
  float2* FS = (float2*)(P.ws + OFF_BIG + BIG_FSCR) + (size_t)blockIdx.x * 40960;
  const float* w4 = P.in[21] + (size_t)l * 64 * 2048;
  const float* cw = P.in[13] + l * 3 * 1536;
  const float* cb = P.in[14] + l * 1536;
  const int tid = otid();
  __syncthreads();
  for (int k = tid; k <= 2048; k += NTHR) { float2 e = TWG[k]; TWL[k] = float2{e.x, -e.y}; }
  __syncthreads();
  for (int it = blockIdx.x; it < 512; it += gridDim.x) {
    const int xcd = it & 7, j = (it >> 3) & 31, grp = (it >> 8) * 8 + xcd;
    const int c = grp * 32 + j;
    __syncthreads();
    if (tid < 256) { int f = tid & 63, wh = tid >> 6; ex[tid] = w4[f * 2048 + (wh >> 1) * 1024 + (wh & 1) * 512 + c]; }
    __syncthreads();
    const float delta = hy_delta(c);
    float n0 = 0.f, n1 = 0.f;
    {
      const int lane = tid & 63, wv = tid >> 6, fr = lane & 15, fq = lane >> 4;
      bf16x8 wa0, wa1;
      {
        unsigned t0[4], t1[4];
#pragma unroll
        for (int j = 0; j < 4; ++j) {
          const float a0 = fr < 4 ? ex[fr * 64 + fq * 8 + 2 * j] : 0.f, a1 = fr < 4 ? ex[fr * 64 + fq * 8 + 2 * j + 1] : 0.f;
          const float c0 = fr < 4 ? ex[fr * 64 + 32 + fq * 8 + 2 * j] : 0.f, c1 = fr < 4 ? ex[fr * 64 + 32 + fq * 8 + 2 * j + 1] : 0.f;
          t0[j] = pack2(a0, a1); t1[j] = pack2(c0, c1);
        }
        wa0 = __builtin_bit_cast(bf16x8, uint4{t0[0], t0[1], t0[2], t0[3]});
        wa1 = __builtin_bit_cast(bf16x8, uint4{t1[0], t1[1], t1[2], t1[3]});
      }
#pragma unroll 4
      for (int g = wv; g < 1024; g += 8) {
        const int n = g * 16 + fr;
        const int dir = n > 8192 ? 1 : 0;
        const int pos = dir ? 16384 - n : n;
        const uint4* hp = (const uint4*)(HID + (size_t)pos * 64 + fq * 8);
        const bf16x8 b0 = __builtin_bit_cast(bf16x8, hp[0]);
        const bf16x8 b1 = __builtin_bit_cast(bf16x8, hp[4]);
        f32x4 d = {0.f, 0.f, 0.f, 0.f};
        d = __builtin_amdgcn_mfma_f32_16x16x32_bf16(wa0, b0, d, 0, 0, 0);
        d = __builtin_amdgcn_mfma_f32_16x16x32_bf16(wa1, b1, d, 0, 0, 0);
        if (fq == 0) {
          float k0 = dir ? d[2] : d[0], k1 = dir ? d[3] : d[1];
          const float win = __expf(-((float)pos / 8191.f) * delta) + 0.05f;
          k0 *= win; k1 *= win;
          if (n == 8192) { k0 = 0.f; k1 = 0.f; }
          n0 += fabsf(k0); n1 += fabsf(k1);
          X[ph(n)] = float2{k0, k1};
        }
      }
    }
    const float norm0 = block_sum(n0, ex + 256), norm1 = block_sum(n1, ex + 272);
    __syncthreads();
    fft_fwd(X, TW);
    {
      const float s0 = 1.f / (norm0 * 16384.f), s1 = 1.f / (norm1 * 16384.f);
#pragma unroll 4
      for (int p = tid; p < 16384; p += NTHR) {
        const int f = (int)(__brev((unsigned)p) >> 18);
        const int p2 = (int)(__brev((unsigned)((16384 - f) & 16383)) >> 18);
        float2 a = X[ph(p)], b = X[ph(p2)];
        FS[p] = float2{(a.x + b.x) * 0.5f * s0, (a.y - b.y) * 0.5f * s0};
        FS[16384 + p] = float2{(a.y + b.y) * 0.5f * s1, -(a.x - b.x) * 0.5f * s1};
      }
    }
    const float cwz0 = cw[1024 + c], cwz1 = cw[1536 + 1024 + c], cwz2 = cw[3072 + 1024 + c], cbz = cb[1024 + c];
    float2* VS = FS + 32768;
    for (int bp = 0; bp < 2; ++bp) {
      const int rb0 = (2 * bp) * 8192, rb1 = rb0 + 8192;
      const u16* z0 = PB + ((size_t)((2 * bp) * 1536 + 1024 + c) << 13);
      const u16* z1 = PB + ((size_t)((2 * bp + 1) * 1536 + 1024 + c) << 13);
#pragma unroll 1
      for (int o = 0; o < 2; ++o) {
        int tl = tid; asm volatile("" : "+v"(tl));
        __syncthreads();
#pragma unroll
        for (int kb = 0; kb < 8; kb += 4) {
          asm volatile("" : "+v"(tl));
          float2 a0[4], a1[4], w1[4];
#pragma unroll
          for (int k = 0; k < 4; ++k) {
            const int q = tl + (kb + k) * NTHR;
            if (o == 0) {
              a0[k].x = conv3_at(z0, q, 8192, cwz0, cwz1, cwz2, cbz);
              a0[k].y = conv3_at(z1, q, 8192, cwz0, cwz1, cwz2, cbz);
              a1[k].x = conv3_at(z0, q + 4096, 8192, cwz0, cwz1, cwz2, cbz);
              a1[k].y = conv3_at(z1, q + 4096, 8192, cwz0, cwz1, cwz2, cbz);
              VS[q] = a0[k]; VS[q + 4096] = a1[k];
            } else { a0[k] = VS[q]; a1[k] = VS[q + 4096]; }
            w1[k] = twd(TW, q);
          }
#pragma unroll
          for (int k = 0; k < 4; ++k) {
            const int q = tl + (kb + k) * NTHR;
            float2 a2 = {0.f, 0.f}, a3 = {0.f, 0.f};
            bfly_fwd(a0[k], a1[k], a2, a3, w1[k]);
            X[ph(q)] = a0[k]; X[ph(q + 4096)] = a1[k]; X[ph(q + 8192)] = a2; X[ph(q + 12288)] = a3;
          }
        }
        __syncthreads();
        fft_pass<false, 11>(X, TW, tl); fft_pass<false, 9>(X, TW, tl); fft_pass<false, 7>(X, TW, tl);
        fft_pass<false, 5>(X, TW, tl); fft_pass<false, 3>(X, TW, tl);
        {
          const float2* Ks = FS + o * 16384;
#pragma unroll
          for (int kb = 0; kb < 8; kb += 4) {
            asm volatile("" : "+v"(tl));
            float2 e0[4], e1[4], e2[4], e3[4];
            float4 kA[4], kB[4];
#pragma unroll
            for (int k = 0; k < 4; ++k) {
              const int q = tl + (kb + k) * NTHR;
              const int r = q & 127, bidx = q >> 7;
              const int p0 = r * 129 + bidx * 4;
              e0[k] = X[p0]; e1[k] = X[p0 + 1]; e2[k] = X[p0 + 2]; e3[k] = X[p0 + 3];
              const float4* kp = (const float4*)(Ks + r * 128 + bidx * 4);
              kA[k] = kp[0]; kB[k] = kp[1];
            }
#pragma unroll
            for (int k = 0; k < 4; ++k) {
              const int q = tl + (kb + k) * NTHR;
              const int r = q & 127, bidx = q >> 7;
              const int p0 = r * 129 + bidx * 4;
              const float2 one = {1.f, 0.f};
              bfly_fwd(e0[k], e1[k], e2[k], e3[k], one);
              e0[k] = cmul(e0[k], float2{kA[k].x, kA[k].y}); e1[k] = cmul(e1[k], float2{kA[k].z, kA[k].w});
              e2[k] = cmul(e2[k], float2{kB[k].x, kB[k].y}); e3[k] = cmul(e3[k], float2{kB[k].z, kB[k].w});
              bfly_inv(e0[k], e1[k], e2[k], e3[k], one);
              X[p0] = e0[k]; X[p0 + 1] = e1[k]; X[p0 + 2] = e2[k]; X[p0 + 3] = e3[k];
            }
          }
          __syncthreads();
        }
        fft_pass<true, 3>(X, TW, tl); fft_pass<true, 5>(X, TW, tl); fft_pass<true, 7>(X, TW, tl);
        fft_pass<true, 9>(X, TW, tl); fft_pass<true, 11>(X, TW, tl);
        const int gc = o * 512 + c;
        const float g0 = cw[gc], g1 = cw[1536 + gc], g2 = cw[3072 + gc], gbias = cb[gc];
        const float skip = P.in[23][(l * 2 + o) * 512 + c];
        const u16* x0p = PB + ((size_t)((2 * bp) * 1536 + gc) << 13);
        const u16* x1p = PB + ((size_t)((2 * bp + 1) * 1536 + gc) << 13);
#pragma unroll
        for (int kb = 0; kb < 8; kb += 4) {
          asm volatile("" : "+v"(tl));
          float2 a0[4], a1[4], a2[4], a3[4], w1[4], vo0[4], vo1[4];
          float xa[4], xb[4], xc2[4], xd[4];
#pragma unroll
          for (int k = 0; k < 4; ++k) {
            const int q = tl + (kb + k) * NTHR;
            a0[k] = X[ph(q)]; a1[k] = X[ph(q + 4096)]; a2[k] = X[ph(q + 8192)]; a3[k] = X[ph(q + 12288)];
            w1[k] = twd(TW, q); w1[k].y = -w1[k].y;
            vo0[k] = VS[q]; vo1[k] = VS[q + 4096];
            xa[k] = conv3_at(x0p, q, 8192, g0, g1, g2, gbias);
            xb[k] = conv3_at(x1p, q, 8192, g0, g1, g2, gbias);
            xc2[k] = conv3_at(x0p, q + 4096, 8192, g0, g1, g2, gbias);
            xd[k] = conv3_at(x1p, q + 4096, 8192, g0, g1, g2, gbias);
          }
#pragma unroll
          for (int k = 0; k < 4; ++k) {
            const int q = tl + (kb + k) * NTHR;
            bfly_inv(a0[k], a1[k], a2[k], a3[k], w1[k]);
            float2 n0v, n1v;
            n0v.x = xa[k] * (a0[k].x + vo0[k].x * skip);
            n0v.y = xb[k] * (a0[k].y + vo0[k].y * skip);
            n1v.x = xc2[k] * (a1[k].x + vo1[k].x * skip);
            n1v.y = xd[k] * (a1[k].y + vo1[k].y * skip);
            if (o == 0) { VS[q] = n0v; VS[q + 4096] = n1v; }
            else {
              YB[(size_t)(rb0 + q) * 512 + c] = f2bf(n0v.x);
              YB[(size_t)(rb1 + q) * 512 + c] = f2bf(n0v.y);
              YB[(size_t)(rb0 + q + 4096) * 512 + c] = f2bf(n1v.x);
              YB[(size_t)(rb1 + q + 4096) * 512 + c] = f2bf(n1v.y);
            }
          }
        }
      }
    }
  }
}

DI void hyena_ctx_phase(const Params& P, int l, unsigned char* smem) {
  float* kf = (float*)smem;
  float* vz = kf + 1024;
  float* red = vz + 1024;
  const u16* PBC = (const u16*)(P.ws + OFF_BIG) + (size_t)4 * 1536 * 8192;
  u16* YB = (u16*)(P.ws + OFF_YB);
  const u16* HID = (const u16*)(P.ws + OFF_HID3) + (size_t)8192 * 64;
  const float* w4 = P.in[21] + (size_t)l * 64 * 2048;
  const float* cw = P.in[13] + l * 3 * 1536;
  const float* cb = P.in[14] + l * 1536;
  const int tid = otid();
  for (int c = blockIdx.x; c < 512; c += gridDim.x) {
    const float delta = hy_delta(c);
    __syncthreads();
    float n0 = 0.f, n1 = 0.f;
    for (int idx = tid; idx < 1024; idx += NTHR) {
      const int pos = idx & 255, wh = idx >> 8, dir = wh >> 1, o = wh & 1;
      float a = 0.f;
      for (int f = 0; f < 64; ++f) a += bf2f(HID[pos * 64 + f]) * w4[f * 2048 + dir * 1024 + o * 512 + c];
      a *= __expf(-((float)pos / 255.f) * delta) + 0.05f;
      kf[idx] = a;
      if (!(dir == 1 && pos == 0)) { if (o == 0) n0 += fabsf(a); else n1 += fabsf(a); }
    }
    const float norm0 = block_sum(n0, red), norm1 = block_sum(n1, red + 16);
    float vreg[2];
    for (int r = 0; r < 2; ++r) {
      const int idx = tid + r * 512, b = idx >> 8, t = idx & 255;
      vreg[r] = conv3_at(PBC + ((size_t)(b * 1536 + 1024 + c) << 8), t, 256, cw[1024 + c], cw[1536 + 1024 + c], cw[3072 + 1024 + c], cb[1024 + c]);
    }
    for (int o = 0; o < 2; ++o) {
      __syncthreads();
      for (int r = 0; r < 2; ++r) vz[tid + r * 512] = vreg[r];
      __syncthreads();
      const float inv = 1.f / (o == 0 ? norm0 : norm1);
      const int gc = o * 512 + c;
      const float skip = P.in[23][(l * 2 + o) * 512 + c];
      for (int r = 0; r < 2; ++r) {
        const int idx = tid + r * 512, b = idx >> 8, t = idx & 255;
        float y = 0.f;
        for (int s = 0; s < 256; ++s) {
          const int lag = t - s;
          float kk = lag >= 0 ? kf[(0 * 2 + o) * 256 + lag] : kf[(1 * 2 + o) * 256 - lag];
          y += kk * vz[b * 256 + s];
        }
        y *= inv;
        float xg = conv3_at(PBC + ((size_t)(b * 1536 + gc) << 8), t, 256, cw[gc], cw[1536 + gc], cw[3072 + gc], cb[gc]);
        vreg[r] = xg * (y + vreg[r] * skip);
      }
    }
    for (int r = 0; r < 2; ++r) {
      const int idx = tid + r * 512, b = idx >> 8, t = idx & 255;
      YB[(size_t)(RL + b * 256 + t) * 512 + c] = f2bf(vreg[r]);
    }
  }
}

DI float rope_inv(int i) { return exp2f(-(float)(2 * i) * (13.287712379549449f / 32.f)); }

DI float axial_rope_lane(float x, int lane, int t) {
  const int sec = lane >> 5, jj = lane & 31, i = jj & 15;
  const float posc = sec ? (float)(t & 63) : (float)(t >> 6);
  float sn, cs;
  sincosf(posc * rope_inv(i), &sn, &cs);
  float partner = shx(x, 16, lane);
  return (jj < 16) ? (x * cs - partner * sn) : (x * cs + partner * sn);
}

DI void mla_e1(const Params& P, int l) {
  u16* PC = (u16*)(P.ws + OFF_BIG);
  const int tid_ = otid(), lane = tid_ & 63, w = tid_ >> 6;
  const float* qan = P.in[24] + l * 256; const float* kvn = P.in[26] + l * 128; const float* krn = P.in[31] + l * 64;
  for (int row = blockIdx.x * 8 + w; row < RA; row += gridDim.x * 8) {
    u16* pr = PC + (size_t)row * 448;
    uint2 qa = *(const uint2*)(pr + lane * 4);
    unsigned kv = *(const unsigned*)(pr + 256 + lane * 2);
    float kr = bf2f(pr[384 + lane]);
    float q0 = blo(qa.x), q1 = bhi(qa.x), q2 = blo(qa.y), q3 = bhi(qa.y);
    float ssq = wave_sum(q0 * q0 + q1 * q1 + q2 * q2 + q3 * q3, lane);
    float rq = rsqrtf(ssq * (1.f / 256.f) + 1e-6f);
    float k0 = blo(kv), k1 = bhi(kv);
    float ssk = wave_sum(k0 * k0 + k1 * k1, lane);
    float rk = rsqrtf(ssk * (1.f / 128.f) + 1e-6f);
    float ssr = wave_sum(kr * kr, lane);
    float rr = rsqrtf(ssr * (1.f / 64.f) + 1e-6f);
    *(uint2*)(pr + lane * 4) = uint2{pack2(q0 * rq * qan[lane * 4], q1 * rq * qan[lane * 4 + 1]), pack2(q2 * rq * qan[lane * 4 + 2], q3 * rq * qan[lane * 4 + 3])};
    *(unsigned*)(pr + 256 + lane * 2) = pack2(k0 * rk * kvn[lane * 2], k1 * rk * kvn[lane * 2 + 1]);
    float x = kr * rr * krn[lane];
    if (row < RL) x = axial_rope_lane(x, lane, row & 8191);
    pr[384 + lane] = f2bf(x);
  }
}

DI void mla_e2(const Params& P, int l) {
  const u16* PC = (const u16*)(P.ws + OFF_BIG);
  u16* Q = (u16*)(P.ws + OFF_BIG + BIG_Q);
  u16* K = (u16*)(P.ws + OFF_BIG + BIG_K);
  const int tid_ = otid(), lane = tid_ & 63, w = tid_ >> 6;
  const float* qnn = P.in[28] + l * 128; const float* qrn = P.in[29] + l * 64; const float* knn = P.in[30] + l * 128;
  const float qscale = 0.07216878364870322f * 1.4426950408889634f;
  for (int row = blockIdx.x * 8 + w; row < RA; row += gridDim.x * 8) {
    u16 krr = PC[(size_t)row * 448 + 384 + lane];
    for (int h = 0; h < 4; ++h) {
      u16* qp = Q + (size_t)row * 768 + h * 192;
      unsigned qn = *(const unsigned*)(qp + lane * 2);
      float qr = bf2f(qp[128 + lane]);
      float a0 = blo(qn), a1 = bhi(qn);
      float r1 = rsqrtf(wave_sum(a0 * a0 + a1 * a1, lane) * (1.f / 128.f) + 1e-6f);
      float r2 = rsqrtf(wave_sum(qr * qr, lane) * (1.f / 64.f) + 1e-6f);
      *(unsigned*)(qp + lane * 2) = pack2(a0 * r1 * qnn[lane * 2] * qscale, a1 * r1 * qnn[lane * 2 + 1] * qscale);
      float x = qr * r2 * qrn[lane];
      if (row < RL) x = axial_rope_lane(x, lane, row & 8191);
      qp[128 + lane] = f2bf(x * qscale);
      u16* kp = K + (size_t)row * 768 + h * 192;
      unsigned kn = *(const unsigned*)(kp + lane * 2);
      float b0 = blo(kn), b1 = bhi(kn);
      float r3 = rsqrtf(wave_sum(b0 * b0 + b1 * b1, lane) * (1.f / 128.f) + 1e-6f);
      *(unsigned*)(kp + lane * 2) = pack2(b0 * r3 * knn[lane * 2], b1 * r3 * knn[lane * 2 + 1]);
      kp[128 + lane] = krr;
    }
  }
}

DI void attn_phase(const Params& P, bool with_ctx_queries, unsigned char* smem) {
  const u16* Q = (const u16*)(P.ws + OFF_BIG + BIG_Q);
  const u16* K = (const u16*)(P.ws + OFF_BIG + BIG_K);
  const u16* VT = (const u16*)(P.ws + OFF_BIG + BIG_VT);
  u16* YC = (u16*)(P.ws + OFF_YC);
  const int tid = otid(), lane = tid & 63, w = tid >> 6, ql = lane & 31, half = lane >> 5;
  const int nitems = 512 + (with_ctx_queries ? 16 : 0);
  for (int it = blockIdx.x; it < nitems; it += gridDim.x) {
    int b, h, qrow0, kt0;
    if (it < 512) { b = it >> 7; h = (it >> 5) & 3; qrow0 = b * 8192 + (it & 31) * 256; kt0 = 0; }
    else { int i2 = it - 512; b = i2 >> 2; h = i2 & 3; qrow0 = RL + b * 256; kt0 = 128; }
    const int qrow = qrow0 + w * 32 + ql;
    bf16x8 qf[12];
    {
      const u16* qp = Q + (size_t)qrow * 768 + h * 192 + half * 8;
#pragma unroll
      for (int ks = 0; ks < 12; ++ks) qf[ks] = *(const bf16x8*)(qp + ks * 16);
    }
    f32x16 O[4];
#pragma unroll
    for (int dt = 0; dt < 4; ++dt)
#pragma unroll
      for (int i = 0; i < 16; ++i) O[dt][i] = 0.f;
    float m_run = -1e30f, l_run = 0.f;
    uint4 pre0, pre1, pre2, pre3, pre4;
#define ATT_GLOAD(KT) do { const int kt_ = (KT); \
      const int krow0 = kt_ < 128 ? b * 8192 + kt_ * 64 : RL + b * 256 + (kt_ - 128) * 64; \
      const u16* kp_ = K + (size_t)(krow0 + (tid >> 3)) * 768 + h * 192 + (tid & 7) * 8; \
      pre0 = *(const uint4*)(kp_); pre1 = *(const uint4*)(kp_ + 64); pre2 = *(const uint4*)(kp_ + 128); \
      const u16* vb_ = VT + ((size_t)(b * 132 + kt_) * 4 + h) * 8192 + tid * 16; \
      pre3 = *(const uint4*)(vb_); pre4 = *(const uint4*)(vb_ + 8); } while (0)
#define ATT_SSTORE(BUF) do { unsigned char* kb_ = smem + (BUF) * 43008 + (tid >> 3) * 400 + (tid & 7) * 16; \
      *(uint4*)(kb_) = pre0; *(uint4*)(kb_ + 128) = pre1; *(uint4*)(kb_ + 256) = pre2; \
      unsigned char* vb2_ = smem + (BUF) * 43008 + 25600 + (tid >> 2) * 136 + (tid & 3) * 32; \
      *(uint4*)(vb2_) = pre3; *(uint4*)(vb2_ + 16) = pre4; } while (0)
    __syncthreads();
    ATT_GLOAD(kt0); ATT_SSTORE(0);
    __syncthreads();
    for (int kt = kt0; kt < 132; ++kt) {
      const bool more = kt + 1 < 132;
      if (more) ATT_GLOAD(kt + 1);
      const unsigned char* kb = smem + ((kt - kt0) & 1) * 43008;
      const unsigned char* vb = kb + 25600;
      f32x16 S[2];
#pragma unroll
      for (int mt = 0; mt < 2; ++mt)
#pragma unroll
        for (int i = 0; i < 16; ++i) S[mt][i] = 0.f;
#define KFRAG(KS, MT) (*(const bf16x8*)(kb + ((MT) * 32 + ql) * 400 + ((KS) * 16 + half * 8) * 2))
      bf16x8 ka0 = KFRAG(0, 0), ka1 = KFRAG(0, 1), kc0, kc1;
      __builtin_amdgcn_sched_barrier(0);
#pragma unroll
      for (int ks = 0; ks < 12; ks += 2) {
        kc0 = KFRAG(ks + 1, 0); kc1 = KFRAG(ks + 1, 1);
        __builtin_amdgcn_sched_barrier(0);
        S[0] = __builtin_amdgcn_mfma_f32_32x32x16_bf16(ka0, qf[ks], S[0], 0, 0, 0);
        S[1] = __builtin_amdgcn_mfma_f32_32x32x16_bf16(ka1, qf[ks], S[1], 0, 0, 0);
        __builtin_amdgcn_sched_barrier(0);
        if (ks + 2 < 12) { ka0 = KFRAG(ks + 2, 0); ka1 = KFRAG(ks + 2, 1); }
        __builtin_amdgcn_sched_barrier(0);
        S[0] = __builtin_amdgcn_mfma_f32_32x32x16_bf16(kc0, qf[ks + 1], S[0], 0, 0, 0);
        S[1] = __builtin_amdgcn_mfma_f32_32x32x16_bf16(kc1, qf[ks + 1], S[1], 0, 0, 0);
        __builtin_amdgcn_sched_barrier(0);
      }
#undef KFRAG
      float mx = S[0][0];
#pragma unroll
      for (int i = 1; i < 16; ++i) mx = fmaxf(mx, S[0][i]);
#pragma unroll
      for (int i = 0; i < 16; ++i) mx = fmaxf(mx, S[1][i]);
      mx = fmaxf(mx, shx(mx, 32, lane));
      const float m_new = fmaxf(m_run, mx);
      const float alpha = __builtin_amdgcn_exp2f(m_run - m_new);
      m_run = m_new;
      float ps = 0.f;
#pragma unroll
      for (int mt = 0; mt < 2; ++mt)
#pragma unroll
        for (int i = 0; i < 16; ++i) { float p = __builtin_amdgcn_exp2f(S[mt][i] - m_new); S[mt][i] = p; ps += p; }
      l_run = l_run * alpha + ps;
      if (__builtin_amdgcn_ballot_w64(alpha != 1.f) != 0) {
#pragma unroll
        for (int dt = 0; dt < 4; ++dt)
#pragma unroll
          for (int i = 0; i < 16; ++i) O[dt][i] *= alpha;
      }
#pragma unroll
      for (int mt = 0; mt < 2; ++mt) {
#pragma unroll
        for (int sp = 0; sp < 2; ++sp) {
          uint4 pk;
          pk.x = pack2(S[mt][8 * sp + 0], S[mt][8 * sp + 1]);
          pk.y = pack2(S[mt][8 * sp + 2], S[mt][8 * sp + 3]);
          pk.z = pack2(S[mt][8 * sp + 4], S[mt][8 * sp + 5]);
          pk.w = pack2(S[mt][8 * sp + 6], S[mt][8 * sp + 7]);
          const bf16x8 pb = __builtin_bit_cast(bf16x8, pk);
          const int k1 = mt * 32 + 16 * sp + 4 * half;
#pragma unroll
          for (int dt = 0; dt < 4; ++dt) {
            const unsigned char* vp = vb + (dt * 32 + ql) * 136 + k1 * 2;
            uint2 lo = *(const uint2*)vp;
            uint2 hi = *(const uint2*)(vp + 16);
            const bf16x8 a = __builtin_bit_cast(bf16x8, uint4{lo.x, lo.y, hi.x, hi.y});
            O[dt] = __builtin_amdgcn_mfma_f32_32x32x16_bf16(a, pb, O[dt], 0, 0, 0);
          }
        }
      }
      if (more) ATT_SSTORE((kt + 1 - kt0) & 1);
      __syncthreads();
    }
    const float lt = l_run + shx(l_run, 32, lane);
    const float inv = 1.f / lt;
    u16* yp = YC + (size_t)qrow * 512 + h * 128;
#pragma unroll
    for (int dt = 0; dt < 4; ++dt)
#pragma unroll
      for (int g = 0; g < 4; ++g) {
        const int dv = dt * 32 + 8 * g + 4 * half;
        *(uint2*)(yp + dv) = uint2{pack2(O[dt][4 * g] * inv, O[dt][4 * g + 1] * inv), pack2(O[dt][4 * g + 2] * inv, O[dt][4 * g + 3] * inv)};
      }
  }
}

DI void ffn_phases(const Params& P, GBar& grid, int l, int f, int nr, unsigned char* smem) {
  u16* WB = (u16*)(P.ws + OFF_WB);
  u16* HB = (u16*)(P.ws + OFF_HB);
  u16* BIG = (u16*)(P.ws + OFF_BIG);
  const u16* W13 = WB + (f == 0 ? W_13A : W_13B);
  const u16* W2 = WB + (f == 0 ? W_2A : W_2B);
  const int gidx = f == 0 ? 2 : 8;
  gemm_phase2(HB, 1024, W13, 1024, 1024, nr, 5632, smem, [&](f32x4 (&acc)[8][4], int rbase, int cbase) {
#pragma unroll
    for (int ct = 0; ct < 8; ct += 2)
#pragma unroll
      for (int tt = 0; tt < 4; ++tt) {
        const int row = rbase + tt * 16;
        const int fq4 = cbase & 12;
        const int j = ((cbase - fq4 + ct * 16) >> 1) + fq4;
        f32x4 a = acc[ct][tt], b = acc[ct + 1][tt];
        *(uint2*)(BIG + (size_t)row * 2816 + j) = uint2{pack2(siluf(a[0]) * b[0], siluf(a[1]) * b[1]), pack2(siluf(a[2]) * b[2], siluf(a[3]) * b[3])};
      }
  });
  grid.sync();
  gemm_phase(BIG, 2816, W2, 2816, 2816, nr, 1024, smem, [&](f32x4 (&acc)[4][4], int rbase, int cbase) {
    float4 g[4];
    const float* mdp = modp(P, l, rbase) + gidx * 1024 + cbase;
#pragma unroll
    for (int ct = 0; ct < 4; ++ct) g[ct] = *(const float4*)(mdp + ct * 16);
#pragma unroll
    for (int tt = 0; tt < 4; ++tt) {
      float4* xp = (float4*)(xrow(P, rbase + tt * 16) + cbase);
      float4 xv[4];
#pragma unroll
      for (int ct = 0; ct < 4; ++ct) xv[ct] = xp[ct * 4];
      __builtin_amdgcn_sched_barrier(0);
#pragma unroll
      for (int ct = 0; ct < 4; ++ct) {
        xv[ct].x += 0.5f * g[ct].x * acc[ct][tt][0]; xv[ct].y += 0.5f * g[ct].y * acc[ct][tt][1];
        xv[ct].z += 0.5f * g[ct].z * acc[ct][tt][2]; xv[ct].w += 0.5f * g[ct].w * acc[ct][tt][3];
      }
#pragma unroll
      for (int ct = 0; ct < 4; ++ct) xp[ct * 4] = xv[ct];
    }
  });
  grid.sync();
}


__global__ void __launch_bounds__(NTHR) fwd_megakernel(Params P) {
  extern __shared__ __attribute__((aligned(16))) unsigned char smem[];
  cg::grid_group cgrid = cg::this_grid();
  GBar grid; grid.bar = (unsigned*)(P.ws + OFF_BAR); grid.post();
  u16* WB = (u16*)(P.ws + OFF_WB);
  u16* HB = (u16*)(P.ws + OFF_HB);
  u16* BIG = (u16*)(P.ws + OFF_BIG);
  u16* YA = (u16*)(P.ws + OFF_YA);
  u16* YB = (u16*)(P.ws + OFF_YB);
  u16* YC = (u16*)(P.ws + OFF_YC);

  mods_phase(P, smem);
  convert_phase(P, 0, smem);
  hid3_phase(P, 0, smem);
  cgrid.sync();
  grid.census();

  for (int l = 0; l < 2; ++l) {
    const int nrows2 = (l == 0) ? RA : RL;
    norm_phase(P, l, 0, RA, l == 0);
    if (l == 1) { convert_phase(P, 1, smem); hid3_phase(P, 1, smem); }
    grid.sync();
    ffn_phases(P, grid, l, 0, RA, smem);
    {

      norm_phase(P, l, 1, RA, false);
      grid.sync();
      gemm_phase2(HB, 1024, WB + W_IN, 1024, 1024, RA, 2560, smem, [&](f32x4 (&acc)[8][4], int rbase, int cbase) {
#pragma unroll
        for (int ct = 0; ct < 8; ++ct)
#pragma unroll
          for (int tt = 0; tt < 4; ++tt) {
            const int row = rbase + tt * 16, col = cbase + ct * 16;
            *(uint2*)(BIG + (size_t)row * 2560 + col) = uint2{pack2(acc[ct][tt][0], acc[ct][tt][1]), pack2(acc[ct][tt][2], acc[ct][tt][3])};
          }
      });
      grid.sync();
      hgrn_h1(P, l, smem);
      grid.sync();
      hgrn_h2(P, smem);
      grid.sync();
      hgrn_h3(P, l, nrows2);
      grid.sync();
      gemm_phase<true>(HB, 1024, WB + W_IN + (size_t)2560 * 1024, 1024, 1024, RA, 1536, smem, [&](f32x4 (&acc)[4][4], int rbase, int cbase) {
#pragma unroll
        for (int ct = 0; ct < 4; ++ct)
#pragma unroll
          for (int tt = 0; tt < 4; ++tt) {
            const int row = rbase + tt * 16, col = cbase + ct * 16;
            u16* dst = row < RL ? BIG + ((size_t)((row >> 13) * 1536 + col) << 13) + (row & 8191)
                                : BIG + (size_t)4 * 1536 * 8192 + ((size_t)(((row - RL) >> 8) * 1536 + col) << 8) + (row & 255);
            *(uint2*)dst = uint2{pack2(acc[ct][tt][0], acc[ct][tt][1]), pack2(acc[ct][tt][2], acc[ct][tt][3])};
          }
      });
      grid.sync();
      hyena_phase(P, l, smem);
      if (l == 0) hyena_ctx_phase(P, l, smem);
      grid.sync();
      gemm_phase(HB, 1024, WB + W_IN + (size_t)4096 * 1024, 1024, 1024, RA, 448, smem, [&](f32x4 (&acc)[4][4], int rbase, int cbase) {
#pragma unroll
        for (int ct = 0; ct < 4; ++ct)
#pragma unroll
          for (int tt = 0; tt < 4; ++tt) {
            const int row = rbase + tt * 16, col = cbase + ct * 16;
            if (col < 448) *(uint2*)(BIG + (size_t)row * 448 + col) = uint2{pack2(acc[ct][tt][0], acc[ct][tt][1]), pack2(acc[ct][tt][2], acc[ct][tt][3])};
          }
      });
      grid.sync();
      mla_e1(P, l);
      grid.sync();
      {
        u16* Qb = (u16*)(P.ws + OFF_BIG + BIG_Q);
        u16* Kb = (u16*)(P.ws + OFF_BIG + BIG_K);
        u16* Vb = (u16*)(P.ws + OFF_BIG + BIG_VT);
        gemm_phase(BIG, 448, WB + W_UQ, 256, 256, RA, 768, smem, [&](f32x4 (&acc)[4][4], int rbase, int cbase) {
#pragma unroll
          for (int ct = 0; ct < 4; ++ct)
#pragma unroll
            for (int tt = 0; tt < 4; ++tt) {
              const int row = rbase + tt * 16, col = cbase + ct * 16;
              *(uint2*)(Qb + (size_t)row * 768 + col) = uint2{pack2(acc[ct][tt][0], acc[ct][tt][1]), pack2(acc[ct][tt][2], acc[ct][tt][3])};
            }
        });
        gemm_phase(BIG + 256, 448, WB + W_UKV, 128, 128, RA, 512, smem, [&](f32x4 (&acc)[4][4], int rbase, int cbase) {
#pragma unroll
          for (int ct = 0; ct < 4; ++ct)
#pragma unroll
            for (int tt = 0; tt < 4; ++tt) {
              const int row = rbase + tt * 16, col = cbase + ct * 16;
              const int hh = col >> 8, jj = col & 255;
              *(uint2*)(Kb + (size_t)row * 768 + hh * 192 + jj) = uint2{pack2(acc[ct][tt][0], acc[ct][tt][1]), pack2(acc[ct][tt][2], acc[ct][tt][3])};
            }
        }, 2, 0);
        gemm_phase<true>(BIG + 256, 448, WB + W_UKV, 128, 128, RA, 512, smem, [&](f32x4 (&acc)[4][4], int rbase, int cbase) {
#pragma unroll
          for (int ct = 0; ct < 4; ++ct)
#pragma unroll
            for (int tt = 0; tt < 4; ++tt) {
              const int row = rbase + tt * 16, col = cbase + ct * 16;
              const int hh = col >> 8, dv = (col & 255) - 128;
              int bb, kt;
              if (row < RL) { bb = row >> 13; kt = (row & 8191) >> 6; } else { int rc = row - RL; bb = rc >> 8; kt = 128 + ((rc & 255) >> 6); }
              u16* vp = Vb + (((size_t)(bb * 132 + kt) * 4 + hh) * 128 + dv) * 64 + (row & 63);
              *(uint2*)vp = uint2{pack2(acc[ct][tt][0], acc[ct][tt][1]), pack2(acc[ct][tt][2], acc[ct][tt][3])};
            }
        }, 2, 1);
      }
      grid.sync();
      mla_e2(P, l);
      grid.sync();
      attn_phase(P, l == 0, smem);
      grid.sync();
      gemm_phase2(HB, 1024, WB + W_IN + (size_t)4544 * 1024, 1024, 1024, nrows2, 3072, smem, [&](f32x4 (&acc)[8][4], int rbase, int cbase) {
#pragma unroll
        for (int ct = 0; ct < 8; ++ct)
#pragma unroll
          for (int tt = 0; tt < 4; ++tt) {
            const int row = rbase + tt * 16, col = cbase + ct * 16;
            *(uint2*)(BIG + (size_t)row * 3072 + col) = uint2{pack2(sigmf(acc[ct][tt][0]), sigmf(acc[ct][tt][1])), pack2(sigmf(acc[ct][tt][2]), sigmf(acc[ct][tt][3]))};
          }
      });
      grid.sync();
      {
        const int ntm = nrows2 >> 8;
        const int tid_ = otid(), lane = tid_ & 63, w = tid_ >> 6, wt = w & 3, wc = w >> 2;
        const TileIter ti(ntm, 8);
        for (int i = 0; i < ti.ntot_it; ++i) {
          int rt_, ct_;
          ti.get(i, rt_, ct_);
          const int row0 = rt_ * 256, col0 = ct_ * 128;
          const int rbase = row0 + wt * 64 + (lane & 15), cbase = col0 + wc * 64 + (lane >> 4) * 4;
          for (int x = 0; x < 3; ++x) {
            f32x4 acc[4][4];
            zero_acc(acc);
            const u16* Yx = x == 0 ? YA : x == 1 ? YB : YC;
            gemm_main(acc, Yx, 512, WB + W_BRA + (size_t)x * 524288, 512, 512, row0, col0, smem);
#pragma unroll
            for (int tt = 0; tt < 4; ++tt) {
              const int row = rbase + tt * 16;
              const u16* gp = BIG + (size_t)row * 3072 + x * 1024 + cbase;
              uint2* mp = (uint2*)(HB + (size_t)row * 1024 + cbase);
              uint2 g[4], o[4];
#pragma unroll
              for (int ct = 0; ct < 4; ++ct) { g[ct] = *(const uint2*)(gp + ct * 16); o[ct] = x > 0 ? mp[ct * 4] : uint2{0u, 0u}; }
              __builtin_amdgcn_sched_barrier(0);
#pragma unroll
              for (int ct = 0; ct < 4; ++ct) {
                const float m0 = blo(g[ct].x) * acc[ct][tt][0] + blo(o[ct].x), m1 = bhi(g[ct].x) * acc[ct][tt][1] + bhi(o[ct].x);
                const float m2 = blo(g[ct].y) * acc[ct][tt][2] + blo(o[ct].y), m3 = bhi(g[ct].y) * acc[ct][tt][3] + bhi(o[ct].y);
                g[ct] = uint2{pack2(m0, m1), pack2(m2, m3)};
              }
#pragma unroll
              for (int ct = 0; ct < 4; ++ct) mp[ct * 4] = g[ct];
            }
          }
        }
      }
      grid.sync();
      gemm_phase(HB, 1024, WB + W_OUT, 1024, 1024, nrows2, 1024, smem, [&](f32x4 (&acc)[4][4], int rbase, int cbase) {
        float4 g[4];
        const float* mdp = modp(P, l, rbase) + 5 * 1024 + cbase;
#pragma unroll
        for (int ct = 0; ct < 4; ++ct) g[ct] = *(const float4*)(mdp + ct * 16);
#pragma unroll
        for (int tt = 0; tt < 4; ++tt) {
          float4* xp = (float4*)(xrow(P, rbase + tt * 16) + cbase);
          float4 xv[4];
#pragma unroll
          for (int ct = 0; ct < 4; ++ct) xv[ct] = xp[ct * 4];
          __builtin_amdgcn_sched_barrier(0);
#pragma unroll
          for (int ct = 0; ct < 4; ++ct) {
            xv[ct].x += g[ct].x * acc[ct][tt][0]; xv[ct].y += g[ct].y * acc[ct][tt][1];
            xv[ct].z += g[ct].z * acc[ct][tt][2]; xv[ct].w += g[ct].w * acc[ct][tt][3];
          }
#pragma unroll
          for (int ct = 0; ct < 4; ++ct) xp[ct * 4] = xv[ct];
        }
      });
      grid.sync();
    }
    norm_phase(P, l, 2, nrows2, false);
    grid.sync();
    ffn_phases(P, grid, l, 1, nrows2, smem);
  }
}

extern "C" void kernel_launch(void* const* d_in, const int* in_sizes, int n_in, void* d_out, int out_size, void* d_ws, size_t ws_size,
                              hipStream_t stream) {
  static int grid_blocks = 0;
  if (!grid_blocks) {
    int dev = 0, cus = 0, per_cu = 0;
    hipGetDevice(&dev);
    hipDeviceGetAttribute(&cus, hipDeviceAttributeMultiprocessorCount, dev);
    hipFuncSetAttribute((const void*)fwd_megakernel, hipFuncAttributeMaxDynamicSharedMemorySize, LDS_BYTES);
    hipOccupancyMaxActiveBlocksPerMultiprocessor(&per_cu, (const void*)fwd_megakernel, NTHR, LDS_BYTES);
    if (per_cu < 1) { fprintf(stderr, "occupancy query says %d blocks/CU\n", per_cu); per_cu = 1; }
    grid_blocks = (cus & ~7);
    if (ws_size < WS_NEED) fprintf(stderr, "workspace too small: %zu < %zu\n", ws_size, (size_t)WS_NEED);
  }
  Params p{};
  for (int i = 0; i < 39; ++i) p.in[i] = (const float*)d_in[i];
  p.out = (float*)d_out;
  p.ws = (unsigned char*)d_ws;
  (void)hipMemsetAsync((unsigned char*)d_ws + OFF_BAR, 0, 16384, stream);
  void* args[] = {&p};
  hipError_t e = hipLaunchCooperativeKernel((const void*)fwd_megakernel, dim3(grid_blocks), dim3(NTHR), args, LDS_BYTES, stream);
  if (e != hipSuccess) fprintf(stderr, "cooperative launch failed: %s (grid %d)\n", hipGetErrorString(e), grid_blocks);
}
```

```cpp
#include <hip/hip_runtime.h>
#include <hip/hip_cooperative_groups.h>
#include <cstdio>
namespace cg = cooperative_groups;

#define DI __device__ __forceinline__
typedef unsigned short u16;
typedef __attribute__((ext_vector_type(8))) short bf16x8;
typedef __attribute__((ext_vector_type(4))) float f32x4;
typedef __attribute__((ext_vector_type(16))) float f32x16;

constexpr int NTHR = 512;
constexpr int RL = 32768, RA = 33792;
constexpr int LDS_BYTES = 151552;

constexpr size_t OFF_MODS = 0;
constexpr size_t OFF_XC   = OFF_MODS + 368640;
constexpr size_t OFF_HID3 = OFF_XC + 4194304;
constexpr size_t OFF_DEC  = OFF_HID3 + 2162688;
constexpr size_t OFF_TW   = OFF_DEC + 2162688;
constexpr size_t OFF_BAR  = OFF_TW + 65536;
constexpr size_t OFF_WB   = OFF_BAR + 16384;
constexpr size_t OFF_HB   = OFF_WB + 56098816;
constexpr size_t OFF_YA   = OFF_HB + 69206016;
constexpr size_t OFF_YB   = OFF_YA + 34603008;
constexpr size_t OFF_YC   = OFF_YB + 34603008;
constexpr size_t OFF_BIG  = OFF_YC + 34603008;
constexpr size_t BIG_FSCR = 104857600;
constexpr size_t BIG_Q    = 30277632;
constexpr size_t BIG_K    = BIG_Q + 51904512;
constexpr size_t BIG_VT   = BIG_K + 51904512;
constexpr size_t WS_NEED  = OFF_BIG + 207618048;
constexpr int W_13A = 0, W_2A = 5767168, W_IN = 8650752, W_UQ = 16449536, W_UKV = 16646144, W_BRA = 16777216,
              W_BRB = 17301504, W_BRC = 17825792, W_OUT = 18350080, W_13B = 19398656, W_2B = 25165824;

struct Params { const float* in[39]; float* out; unsigned char* ws; };

DI int otid() { int t = __builtin_amdgcn_workitem_id_x(); asm volatile("" : "+v"(t)); return t; }
typedef float f32x2_t __attribute__((ext_vector_type(2)));
typedef __bf16 bf16x2_t __attribute__((ext_vector_type(2)));
DI unsigned pack2(float a, float b) { f32x2_t v = {a, b}; bf16x2_t r = __builtin_convertvector(v, bf16x2_t); return __builtin_bit_cast(unsigned, r); }
DI u16 f2bf(float x) { return (u16)(pack2(x, x) & 0xffffu); }
DI float bf2f(u16 h) { return __uint_as_float(((unsigned)h) << 16); }
DI float blo(unsigned u) { return __uint_as_float(u << 16); }
DI float bhi(unsigned u) { return __uint_as_float(u & 0xffff0000u); }
DI float siluf(float x) { return x / (1.f + __expf(-x)); }
DI float sigmf(float x) { return 1.f / (1.f + __expf(-x)); }
DI float shx(float v, int mask, int lane) { return __int_as_float(__builtin_amdgcn_ds_bpermute((lane ^ mask) << 2, __float_as_int(v))); }
DI float row16_sum(float v) {
  v += __int_as_float(__builtin_amdgcn_update_dpp(0, __float_as_int(v), 0xB1, 0xF, 0xF, true));
  v += __int_as_float(__builtin_amdgcn_update_dpp(0, __float_as_int(v), 0x4E, 0xF, 0xF, true));
  v += __int_as_float(__builtin_amdgcn_update_dpp(0, __float_as_int(v), 0x141, 0xF, 0xF, true));
  v += __int_as_float(__builtin_amdgcn_update_dpp(0, __float_as_int(v), 0x140, 0xF, 0xF, true));
  return v;
}
DI float wave_sum(float v, int lane) {
  (void)lane;
  v = row16_sum(v);
  const int iv = __float_as_int(v);
  return __int_as_float(__builtin_amdgcn_readlane(iv, 0)) + __int_as_float(__builtin_amdgcn_readlane(iv, 16)) +
         __int_as_float(__builtin_amdgcn_readlane(iv, 32)) + __int_as_float(__builtin_amdgcn_readlane(iv, 48));
}
DI float* xrow(const Params& P, int r) { return r < RL ? P.out + (size_t)r * 1024 : (float*)(P.ws + OFF_XC) + (size_t)(r - RL) * 1024; }
DI const float* modp(const Params& P, int l, int r) { int mi = r < RL ? (r >> 13) : 4; return (const float*)(P.ws + OFF_MODS) + (size_t)(l * 5 + mi) * 9216; }
DI float block_sum(float v, float* red) {
  const int t_ = otid();
  v = wave_sum(v, t_ & 63);
  __syncthreads();
  if ((t_ & 63) == 0) red[t_ >> 6] = v;
  __syncthreads();
  float s = 0.f;
  for (int i = 0; i < 8; ++i) s += red[i];
  return s;
}

#define XB_XCNT(j) (256 + 64 * (j))
#define XB_XSUB(j) (1280 + 64 * (j))
#define XB_XGEN(j) (2304 + 64 * (j))
#define XB_TOP 3328
#define XB_TOPGEN 3392
DI unsigned xb_ld(unsigned* p) { return __hip_atomic_load(p, __ATOMIC_RELAXED, __HIP_MEMORY_SCOPE_AGENT); }
DI unsigned xb_add(unsigned* p, unsigned v) { return __hip_atomic_fetch_add(p, v, __ATOMIC_RELAXED, __HIP_MEMORY_SCOPE_AGENT); }
DI unsigned xb_xcc_id() { return (unsigned)__builtin_amdgcn_s_getreg((3 << 11) | 20) & 0xFu; }
struct GBar {
  unsigned* bar; unsigned x, nloc, nx, gen;
  DI void post() { x = xb_xcc_id(); if (__builtin_amdgcn_workitem_id_x() == 0) (void)xb_add(&bar[XB_XCNT(x)], 1u); }
  DI void census() {
    unsigned mine = 0, cnt = 0;
    for (unsigned j = 0; j < 16; ++j) { const unsigned c = xb_ld(&bar[XB_XCNT(j)]); cnt += c > 0u ? 1u : 0u; mine = j == x ? c : mine; }
    nloc = __builtin_amdgcn_readfirstlane(mine > 0u ? mine : 1u); nx = __builtin_amdgcn_readfirstlane(cnt > 0u ? cnt : 1u); gen = 0;
  }
  DI void sync() {
    asm volatile("s_waitcnt vmcnt(0)" ::: "memory");
    __syncthreads();
    if (__builtin_amdgcn_workitem_id_x() == 0) {
      __builtin_amdgcn_s_waitcnt(0);
      const unsigned old = xb_add(&bar[XB_XSUB(x)], 1u);
      if (old + 1u == (gen + 1u) * nloc) {
        __builtin_amdgcn_fence(__ATOMIC_RELEASE, "agent");
        asm volatile("s_waitcnt vmcnt(0)" ::: "memory");
        const unsigned og = xb_add(&bar[XB_TOP], 1u);
        if (og + 1u == (gen + 1u) * nx) xb_add(&bar[XB_TOPGEN], 1u);
        else { while (xb_ld(&bar[XB_TOPGEN]) == gen) __builtin_amdgcn_s_sleep(1); }
        __builtin_amdgcn_fence(__ATOMIC_ACQUIRE, "agent");
        xb_add(&bar[XB_XGEN(x)], 1u);
        asm volatile("s_waitcnt vmcnt(0)" ::: "memory");
      } else {
        while (xb_ld(&bar[XB_XGEN(x)]) == gen) __builtin_amdgcn_s_sleep(1);
        __builtin_amdgcn_fence(__ATOMIC_ACQUIRE, "agent");
        asm volatile("s_waitcnt vmcnt(0)" ::: "memory");
      }
    }
    gen += 1u;
    __syncthreads();
  }
};

DI void mods_phase(const Params& P, unsigned char* smem) {
  float* s = (float*)smem;
  const int tid = otid();
  {
    float2* TW = (float2*)(P.ws + OFF_TW);
    for (int k = blockIdx.x * NTHR + tid; k < 8192; k += gridDim.x * NTHR) {
      float sn, cs;
      sincospif((float)k * (1.f / 8192.f), &sn, &cs);
      TW[k] = float2{cs, -sn};
    }
  }
  for (int it = blockIdx.x; it < 36; it += gridDim.x) {
    const int l = it / 18, n = (it % 18) * 512 + tid;
    __syncthreads();
    for (int i = tid; i < 5120; i += NTHR) { float c = i < 4096 ? P.in[1][i] : P.in[3][i - 4096]; s[i] = siluf(c); }
    __syncthreads();
    float a0 = 0, a1 = 0, a2 = 0, a3 = 0, a4 = 0;
    const float* w = P.in[4] + (size_t)l * 1024 * 9216 + n;
#pragma unroll 8
    for (int k = 0; k < 1024; ++k) {
      float wv = w[(size_t)k * 9216];
      a0 += s[k] * wv; a1 += s[1024 + k] * wv; a2 += s[2048 + k] * wv; a3 += s[3072 + k] * wv; a4 += s[4096 + k] * wv;
    }
    float bb = P.in[5][l * 9216 + n];
    float* m = (float*)(P.ws + OFF_MODS) + (size_t)l * 5 * 9216 + n;
    m[0] = a0 + bb; m[9216] = a1 + bb; m[2 * 9216] = a2 + bb; m[3 * 9216] = a3 + bb; m[4 * 9216] = a4 + bb;
  }
}

DI void hid3_phase(const Params& P, int l, unsigned char* smem) {
  float* emb = (float*)smem;
  float* hA = emb + 64 * 33;
  float* hB = hA + 64 * 65;
  const int tid = otid(), p = tid & 63, fg = tid >> 6;
  const float* w1 = P.in[15] + l * 33 * 64; const float* b1 = P.in[16] + l * 64;
  const float* w2 = P.in[17] + l * 4096;    const float* b2 = P.in[18] + l * 64;
  const float* w3 = P.in[19] + l * 4096;    const float* b3 = P.in[20] + l * 64;
  const float* fr = P.in[22] + l * 64;
  u16* HID = (u16*)(P.ws + OFF_HID3);
  for (int it = blockIdx.x; it < 132; it += gridDim.x) {
    const int L = it < 128 ? 8192 : 256;
    const int pos0 = it < 128 ? it * 64 : (it - 128) * 64;
    u16* outp = HID + (size_t)(it < 128 ? pos0 : 8192 + pos0) * 64;
    __syncthreads();
    for (int e = tid; e < 64 * 33; e += NTHR) {
      int pp = e / 33, j = e % 33;
      float posf = (float)(pos0 + pp);
      float tl = posf / (float)(L - 1);
      float wang = (6.283185307179586f / (float)L) * posf;
      float v;
      if (j == 0) v = tl;
      else {
        int bi = (j - 1) & 15;
        float band = 1e-4f + (float)bi * ((15.f - 1e-4f) / 15.f);
        float ang = band * wang;
        v = (j <= 16) ? cosf(ang) : -sinf(ang);
      }
      emb[pp * 33 + j] = v;
    }
    __syncthreads();
    for (int ff = 0; ff < 8; ++ff) {
      int f = fg * 8 + ff; float a = b1[f];
      for (int j = 0; j < 33; ++j) a += emb[p * 33 + j] * w1[j * 64 + f];
      hA[p * 65 + f] = sinf(fr[f] * a);
    }
    __syncthreads();
    for (int ff = 0; ff < 8; ++ff) {
      int f = fg * 8 + ff; float a = b2[f];
      for (int j = 0; j < 64; ++j) a += hA[p * 65 + j] * w2[j * 64 + f];
      hB[p * 65 + f] = sinf(fr[f] * a);
    }
    __syncthreads();
    for (int ff = 0; ff < 8; ++ff) {
      int f = fg * 8 + ff; float a = b3[f];
      for (int j = 0; j < 64; ++j) a += hB[p * 65 + j] * w3[j * 64 + f];
      outp[p * 64 + f] = f2bf(sinf(fr[f] * a));
    }
  }
}

DI void conv_tile(const float* __restrict__ src, int K, int N, u16* __restrict__ dst, int tile, bool perm13, unsigned char* smem) {
  float* t = (float*)smem;
  const int tid = otid();
  const int ntn = N >> 6;
  const int k0 = (tile / ntn) * 64, n0 = (tile % ntn) * 64;
  __syncthreads();
  {
    int kk = tid >> 4, nn = (tid & 15) * 4;
    for (int it = 0; it < 2; ++it) {
      float4 v = *(const float4*)(src + (size_t)(k0 + kk + 32 * it) * N + n0 + nn);
      float* d = t + (kk + 32 * it) * 65 + nn;
      d[0] = v.x; d[1] = v.y; d[2] = v.z; d[3] = v.w;
    }
  }
  __syncthreads();
  {
    int nn = tid >> 3, kc = (tid & 7) * 8;
    int n = n0 + nn;
    if (perm13) { n = n < 2816 ? ((n >> 4) * 32 + (n & 15)) : (((n - 2816) >> 4) * 32 + 16 + ((n - 2816) & 15)); }
    uint4 o;
    o.x = pack2(t[(kc + 0) * 65 + nn], t[(kc + 1) * 65 + nn]);
    o.y = pack2(t[(kc + 2) * 65 + nn], t[(kc + 3) * 65 + nn]);
    o.z = pack2(t[(kc + 4) * 65 + nn], t[(kc + 5) * 65 + nn]);
    o.w = pack2(t[(kc + 6) * 65 + nn], t[(kc + 7) * 65 + nn]);
    *(uint4*)(dst + (size_t)n * K + k0 + kc) = o;
  }
}

DI void convert_phase(const Params& P, int l, unsigned char* smem) {
  u16* WB = (u16*)(P.ws + OFF_WB);
  for (int it = blockIdx.x; it < 6848; it += gridDim.x) {
    int i = it;
    if (i < 1408) { conv_tile(P.in[7] + (size_t)l * 1024 * 5632, 1024, 5632, WB + W_13A, i, true, smem); continue; } i -= 1408;
    if (i < 704)  { conv_tile(P.in[8] + (size_t)l * 2816 * 1024, 2816, 1024, WB + W_2A, i, false, smem); continue; } i -= 704;
    if (i < 1904) { conv_tile(P.in[10] + (size_t)l * 1024 * 7616, 1024, 7616, WB + W_IN, i, false, smem); continue; } i -= 1904;
    if (i < 48)   { conv_tile(P.in[25] + (size_t)l * 256 * 768, 256, 768, WB + W_UQ, i, false, smem); continue; } i -= 48;
    if (i < 32)   { conv_tile(P.in[27] + (size_t)l * 128 * 1024, 128, 1024, WB + W_UKV, i, false, smem); continue; } i -= 32;
    if (i < 128)  { conv_tile(P.in[32] + (size_t)l * 512 * 1024, 512, 1024, WB + W_BRA, i, false, smem); continue; } i -= 128;
    if (i < 128)  { conv_tile(P.in[33] + (size_t)l * 512 * 1024, 512, 1024, WB + W_BRB, i, false, smem); continue; } i -= 128;
    if (i < 128)  { conv_tile(P.in[34] + (size_t)l * 512 * 1024, 512, 1024, WB + W_BRC, i, false, smem); continue; } i -= 128;
    if (i < 256)  { conv_tile(P.in[35] + (size_t)l * 1024 * 1024, 1024, 1024, WB + W_OUT, i, false, smem); continue; } i -= 256;
    if (i < 1408) { conv_tile(P.in[37] + (size_t)l * 1024 * 5632, 1024, 5632, WB + W_13B, i, true, smem); continue; } i -= 1408;
    conv_tile(P.in[38] + (size_t)l * 2816 * 1024, 2816, 1024, WB + W_2B, i, false, smem);
  }
}

DI void norm_phase(const Params& P, int l, int which, int nrows, bool first) {
  const int tid_ = otid(), lane = tid_ & 63, w = tid_ >> 6;
  const float* gw = (which == 0 ? P.in[6] : which == 1 ? P.in[9] : P.in[36]) + l * 1024;
  u16* HB = (u16*)(P.ws + OFF_HB);
  for (int row = blockIdx.x * 8 + w; row < nrows; row += gridDim.x * 8) {
    float* xr = xrow(P, row);
    const float* src = first ? (row < RL ? P.in[0] + (size_t)row * 1024 : P.in[2] + (size_t)(row - RL) * 1024) : xr;
    float4 v[4];
    float ss = 0.f;
    for (int j = 0; j < 4; ++j) {
      v[j] = ((const float4*)src)[j * 64 + lane];
      ss += v[j].x * v[j].x + v[j].y * v[j].y + v[j].z * v[j].z + v[j].w * v[j].w;
    }
    ss = wave_sum(ss, lane);
    float rstd = rsqrtf(ss * (1.f / 1024.f) + 1e-6f);
    const float* md = modp(P, l, row) + which * 3 * 1024;
    for (int j = 0; j < 4; ++j) {
      if (first) ((float4*)xr)[j * 64 + lane] = v[j];
      int col = (j * 64 + lane) * 4;
      float4 g = *(const float4*)(gw + col);
      float4 sh = *(const float4*)(md + col);
      float4 sc = *(const float4*)(md + 1024 + col);
      uint2 o;
      o.x = pack2(v[j].x * rstd * g.x * (1.f + sc.x) + sh.x, v[j].y * rstd * g.y * (1.f + sc.y) + sh.y);
      o.y = pack2(v[j].z * rstd * g.z * (1.f + sc.z) + sh.z, v[j].w * rstd * g.w * (1.f + sc.w) + sh.w);
      *(uint2*)(HB + (size_t)row * 1024 + col) = o;
    }
  }
}

#define LDSP(p) ((__attribute__((address_space(3))) unsigned*)(p))
#define GLBP(p) ((__attribute__((address_space(1))) const unsigned*)(p))
#define WAIT_VM(n) asm volatile("s_waitcnt vmcnt(" #n ")" ::: "memory")
#define RAW_BARRIER() do { asm volatile("s_waitcnt lgkmcnt(0)" ::: "memory"); __builtin_amdgcn_s_barrier(); asm volatile("" ::: "memory"); } while (0)

template <bool SWAP = false>
DI void gemm_main(f32x4 (&acc)[4][4], const u16* __restrict__ Act, int lda, const u16* __restrict__ Wt, int ldw, int K,
                  int row0, int col0, unsigned char* smem) {
  const int tid = otid(), lane = tid & 63, w = tid >> 6, wt = w & 3, wc = w >> 2;
  const int lr = tid >> 3, lc = (tid & 7) ^ ((lr >> 1) & 7);
  const u16* srcA = Act + (size_t)(row0 + lr) * lda + lc * 8;
  const u16* srcW = Wt + (size_t)(col0 + lr) * ldw + lc * 8;
  const int nk = K >> 6;
  const int fr = lane & 15, fq = lane >> 4, key = (fr >> 1) & 7;
  unsigned char* wbase = smem + w * 1024;
#define GM_DMA(KT, ST) do { const int k0_ = (KT) * 64; unsigned char* d_ = wbase + (ST) * 49152; \
    __builtin_amdgcn_global_load_lds(GLBP(srcA + k0_), LDSP(d_), 16, 0, 0); \
    __builtin_amdgcn_global_load_lds(GLBP(srcA + (size_t)64 * lda + k0_), LDSP(d_ + 8192), 16, 0, 0); \
    __builtin_amdgcn_global_load_lds(GLBP(srcA + (size_t)128 * lda + k0_), LDSP(d_ + 16384), 16, 0, 0); \
    __builtin_amdgcn_global_load_lds(GLBP(srcA + (size_t)192 * lda + k0_), LDSP(d_ + 24576), 16, 0, 0); \
    __builtin_amdgcn_global_load_lds(GLBP(srcW + k0_), LDSP(d_ + 32768), 16, 0, 0); \
    __builtin_amdgcn_global_load_lds(GLBP(srcW + (size_t)64 * ldw + k0_), LDSP(d_ + 40960), 16, 0, 0); } while (0)
#define GM_FRAGS(A_, B_, ST, KS) do { const unsigned char* base_ = smem + (ST) * 49152; const int po_ = (((KS) * 4 + fq) ^ key) * 16; \
    _Pragma("unroll") for (int ct = 0; ct < 4; ++ct) A_[ct] = *(const bf16x8*)(base_ + (256 + wc * 64 + ct * 16 + fr) * 128 + po_); \
    _Pragma("unroll") for (int tt = 0; tt < 4; ++tt) B_[tt] = *(const bf16x8*)(base_ + (wt * 64 + tt * 16 + fr) * 128 + po_); } while (0)
#define GM_MMA(A_, B_) do { \
    _Pragma("unroll") for (int ct = 0; ct < 4; ++ct) \
      _Pragma("unroll") for (int tt = 0; tt < 4; ++tt) \
        acc[ct][tt] = SWAP ? __builtin_amdgcn_mfma_f32_16x16x32_bf16(B_[tt], A_[ct], acc[ct][tt], 0, 0, 0) \
                           : __builtin_amdgcn_mfma_f32_16x16x32_bf16(A_[ct], B_[tt], acc[ct][tt], 0, 0, 0); } while (0)
  bf16x8 fa0[4], fb0[4], fa1[4], fb1[4];
  WAIT_VM(0);
  RAW_BARRIER();
  GM_DMA(0, 0);
  if (nk > 1) GM_DMA(1, 1);
  if (nk > 2) GM_DMA(2, 2);
  if (nk > 2) WAIT_VM(12); else if (nk > 1) WAIT_VM(6); else WAIT_VM(0);
  RAW_BARRIER();
  GM_FRAGS(fa0, fb0, 0, 0);
  int st = 0;
  for (int kt = 0; kt < nk; ++kt) {
    const int st1 = st == 2 ? 0 : st + 1;
    GM_FRAGS(fa1, fb1, st, 1);
    GM_MMA(fa0, fb0);
    if (kt + 1 < nk) {
      if (kt + 2 < nk) WAIT_VM(6); else WAIT_VM(0);
      RAW_BARRIER();
      if (kt + 3 < nk) GM_DMA(kt + 3, st);
      GM_FRAGS(fa0, fb0, st1, 0);
    }
    GM_MMA(fa1, fb1);
    st = st1;
  }
#undef GM_FRAGS
#undef GM_MMA
#undef GM_DMA
}

DI void zero_acc(f32x4 (&acc)[4][4]) {
#pragma unroll
  for (int a = 0; a < 4; ++a)
#pragma unroll
    for (int b = 0; b < 4; ++b) acc[a][b] = f32x4{0.f, 0.f, 0.f, 0.f};
}

struct TileIter {
  int ntn, nmain_it, ntot_it, x, slot, nslot, rem0;
  DI TileIter(int ntm, int ntn_) {
    ntn = ntn_;
    x = blockIdx.x & 7; slot = blockIdx.x >> 3; nslot = gridDim.x >> 3;
    const int nmain = (ntm >> 3) * ntn;
    rem0 = (ntm >> 3) << 3;
    const int nrem = (ntm - rem0) * ntn;
    nmain_it = slot < nmain ? (nmain - slot + nslot - 1) / nslot : 0;
    const int nrem_it = (int)blockIdx.x < nrem ? (nrem - (int)blockIdx.x + (int)gridDim.x - 1) / (int)gridDim.x : 0;
    ntot_it = nmain_it + nrem_it;
  }
  DI void get(int i, int& rt, int& ct) const {
    if (i < nmain_it) { const int q = slot + i * nslot; rt = (q / ntn) * 8 + x; ct = q % ntn; }
    else { const int j = blockIdx.x + (i - nmain_it) * gridDim.x; rt = rem0 + j / ntn; ct = j % ntn; }
  }
};

template <bool SWAP = false, class Epi>
DI void gemm_phase(const u16* Act, int lda, const u16* Wt, int ldw, int K, int Mrows, int Ncols, unsigned char* smem, Epi epi,
                   int ct_mul = 1, int ct_off = 0) {
  const int ntn = (Ncols + 127) >> 7, ntm = Mrows >> 8;
  const int tid_ = otid(), lane = tid_ & 63, w = tid_ >> 6, wt = w & 3, wc = w >> 2;
  const TileIter ti(ntm, ntn);
  for (int i = 0; i < ti.ntot_it; ++i) {
    int rt_, ct_;
    ti.get(i, rt_, ct_);
    const int row0 = rt_ * 256, col0 = (ct_ * ct_mul + ct_off) * 128;
    f32x4 acc[4][4];
    zero_acc(acc);
    gemm_main<SWAP>(acc, Act, lda, Wt, ldw, K, row0, col0, smem);
    const int rbase = row0 + wt * 64 + (SWAP ? (lane >> 4) * 4 : (lane & 15));
    const int cbase = col0 + wc * 64 + (SWAP ? (lane & 15) : (lane >> 4) * 4);
    epi(acc, rbase, cbase);
  }
}

DI void gemm_main2(f32x4 (&acc)[8][4], const u16* __restrict__ Act, int lda, const u16* __restrict__ Wt, int ldw, int K,
                   int row0, int col0, unsigned char* smem) {
  const int tid = otid(), lane = tid & 63, w = tid >> 6, wt = w & 3, wc = w >> 2;
  const int lr = tid >> 2, lc = (tid & 3) ^ ((lr >> 2) & 3);
  const u16* srcA = Act + (size_t)(row0 + lr) * lda + lc * 8;
  const u16* srcW = Wt + (size_t)(col0 + lr) * ldw + lc * 8;
  const int nk = K >> 5;
  const int fr = lane & 15, fq = lane >> 4;
  const int po = (fq ^ ((fr >> 2) & 3)) * 16;
  unsigned char* wbase = smem + w * 1024;
#define G2_DMA(KT, ST) do { const int k0_ = (KT) * 32; unsigned char* d_ = wbase + (ST) * 32768; \
    __builtin_amdgcn_global_load_lds(GLBP(srcA + k0_), LDSP(d_), 16, 0, 0); \
    __builtin_amdgcn_global_load_lds(GLBP(srcA + (size_t)128 * lda + k0_), LDSP(d_ + 8192), 16, 0, 0); \
    __builtin_amdgcn_global_load_lds(GLBP(srcW + k0_), LDSP(d_ + 16384), 16, 0, 0); \
    __builtin_amdgcn_global_load_lds(GLBP(srcW + (size_t)128 * ldw + k0_), LDSP(d_ + 24576), 16, 0, 0); } while (0)
  WAIT_VM(0);
  RAW_BARRIER();
  G2_DMA(0, 0);
  if (nk > 1) G2_DMA(1, 1);
  int st = 0;
  for (int kt = 0; kt < nk; ++kt) {
    if (kt + 1 < nk) WAIT_VM(4); else WAIT_VM(0);
    RAW_BARRIER();
    if (kt + 2 < nk) { const int s2 = st >= 1 ? st - 1 : 2; G2_DMA(kt + 2, s2); }
    const unsigned char* base = smem + st * 32768;
    __builtin_amdgcn_iglp_opt(1);
    bf16x8 a[8], b[4];
#pragma unroll
    for (int ct = 0; ct < 8; ++ct) a[ct] = *(const bf16x8*)(base + (256 + wc * 128 + ct * 16 + fr) * 64 + po);
#pragma unroll
    for (int tt = 0; tt < 4; ++tt) b[tt] = *(const bf16x8*)(base + (wt * 64 + tt * 16 + fr) * 64 + po);
#pragma unroll
    for (int ct = 0; ct < 8; ++ct)
#pragma unroll
      for (int tt = 0; tt < 4; ++tt) acc[ct][tt] = __builtin_amdgcn_mfma_f32_16x16x32_bf16(a[ct], b[tt], acc[ct][tt], 0, 0, 0);
    st = st == 2 ? 0 : st + 1;
  }
#undef G2_DMA
}

template <class Epi>
DI void gemm_phase2(const u16* Act, int lda, const u16* Wt, int ldw, int K, int Mrows, int Ncols, unsigned char* smem, Epi epi) {
  const int ntn = Ncols >> 8, ntm = Mrows >> 8;
  const int tid_ = otid(), lane = tid_ & 63, w = tid_ >> 6, wt = w & 3, wc = w >> 2;
  const TileIter ti(ntm, ntn);
  for (int i = 0; i < ti.ntot_it; ++i) {
    int rt_, ct_;
    ti.get(i, rt_, ct_);
    const int row0 = rt_ * 256, col0 = ct_ * 256;
    f32x4 acc[8][4];
#pragma unroll
    for (int a = 0; a < 8; ++a)
#pragma unroll
      for (int b = 0; b < 4; ++b) acc[a][b] = f32x4{0.f, 0.f, 0.f, 0.f};
    gemm_main2(acc, Act, lda, Wt, ldw, K, row0, col0, smem);
    epi(acc, row0 + wt * 64 + (lane & 15), col0 + wc * 128 + (lane >> 4) * 4);
  }
}

DI float lb_value(const Params& P, int dir, int l, int k) {
  if (l == 0) return 0.f;
  float a = P.in[11][(dir * 2 + 0) * 512 + k], b = P.in[11][(dir * 2 + 1) * 512 + k];
  float m = fmaxf(a, b);
  float ea = __expf(a - m), eb = __expf(b - m);
  return eb / (ea + eb);
}

DI void hgrn_h1(const Params& P, int l, unsigned char* smem) {
  u16* PA = (u16*)(P.ws + OFF_BIG);
  u16* YA = (u16*)(P.ws + OFF_YA);
  u16* OF = (u16*)(P.ws + OFF_YB);
  u16* OB = (u16*)(P.ws + OFF_YC);
  float* DEC = (float*)(P.ws + OFF_DEC);
  u16* sQF = (u16*)smem;
  u16* sKF = sQF + 64 * 136;
  u16* sQB = sKF + 64 * 136;
  u16* sKB = sQB + 64 * 136;
  u16* sVT = sKB + 64 * 136;
  u16* sAT = sVT + 128 * 72;
  float* ps = (float*)(sAT + 2 * 64 * 72);
  const int tid = otid(), lane = tid & 63, w = tid >> 6;
  const int d = tid & 127, sq = tid >> 7;
  for (int it = blockIdx.x; it < 528 * 4; it += gridDim.x) {
    const int ch = it >> 2, h = it & 3;
    const int row0 = ch * 64;
    const float lbf = lb_value(P, 0, l, h * 128 + d), lbb = lb_value(P, 1, l, h * 128 + d);
    float gf[16], gb[16], kf[16], kb[16], qs[16];
    u16 vv[16];
    float pf = 0.f, pb = 0.f;
    {
      const u16* src = PA + (size_t)(row0 + sq * 16) * 2560 + h * 128 + d;
#pragma unroll
      for (int j = 0; j < 16; ++j) {
        float q = bf2f(src[(size_t)j * 2560]);
        float zf = bf2f(src[(size_t)j * 2560 + 512]);
        float zb = bf2f(src[(size_t)j * 2560 + 1024]);
        vv[j] = src[(size_t)j * 2560 + 1536];
        qs[j] = siluf(q) * 0.08838834764831845f;
        float sf = sigmf(zf), sb = sigmf(zb);
        float ff = lbf + (1.f - lbf) * sf, fb = lbb + (1.f - lbb) * sb;
        gf[j] = __logf(ff); gb[j] = __logf(fb);
        kf[j] = (1.f - lbf) * (1.f - sf); kb[j] = (1.f - lbb) * (1.f - sb);
        pf += gf[j]; pb += gb[j];
      }
    }
    asm volatile("s_waitcnt vmcnt(0)" ::: "memory");
    __syncthreads();
    ps[(0 * 4 + sq) * 128 + d] = pf;
    ps[(1 * 4 + sq) * 128 + d] = pb;
    __syncthreads();
    float offf = 0.f, totf = 0.f, offb = 0.f, totb = 0.f;
#pragma unroll
    for (int s2 = 0; s2 < 4; ++s2) {
      float a = ps[s2 * 128 + d], b = ps[(4 + s2) * 128 + d];
      totf += a; totb += b;
      if (s2 < sq) offf += a;
      if (s2 > sq) offb += b;
    }
    if (sq == 0) {
      DEC[((size_t)(0 * 528 + ch) * 4 + h) * 128 + d] = __expf(totf);
      DEC[((size_t)(1 * 528 + ch) * 4 + h) * 128 + d] = __expf(totb);
    }
    {
      unsigned kh[8];
      float bc = offf;
#pragma unroll
      for (int j = 0; j < 16; ++j) {
        bc += gf[j];
        const int s = sq * 16 + j;
        u16 qt = f2bf(qs[j] * __expf(bc));
        sQF[s * 136 + d] = qt;
        sKF[s * 136 + d] = f2bf(kf[j] * __expf(fminf(-bc, 80.f)));
        PA[(size_t)(row0 + s) * 2560 + h * 128 + d] = qt;
        u16 khv = f2bf(kf[j] * __expf(totf - bc));
        if (j & 1) kh[j >> 1] |= ((unsigned)khv) << 16; else kh[j >> 1] = khv;
      }
      u16* dst = PA + (size_t)(row0 + (d >> 1)) * 2560 + 512 + h * 128 + (d & 1) * 64 + sq * 16;
      *(uint4*)dst = uint4{kh[0], kh[1], kh[2], kh[3]};
      *(uint4*)(dst + 8) = uint4{kh[4], kh[5], kh[6], kh[7]};
    }
    {
      unsigned kh[8];
      float bc = offb;
#pragma unroll
      for (int j = 15; j >= 0; --j) {
        bc += gb[j];
        const int s = sq * 16 + j;
        u16 qt = f2bf(qs[j] * __expf(bc));
        sQB[s * 136 + d] = qt;
        sKB[s * 136 + d] = f2bf(kb[j] * __expf(fminf(-bc, 80.f)));
        YA[(size_t)(row0 + s) * 512 + h * 128 + d] = qt;
        u16 khv = f2bf(kb[j] * __expf(totb - bc));
        if (j & 1) kh[j >> 1] = ((unsigned)khv) << 16; else kh[j >> 1] |= khv;
      }
      u16* dst = PA + (size_t)(row0 + (d >> 1)) * 2560 + 1024 + h * 128 + (d & 1) * 64 + sq * 16;
      *(uint4*)dst = uint4{kh[0], kh[1], kh[2], kh[3]};
      *(uint4*)(dst + 8) = uint4{kh[4], kh[5], kh[6], kh[7]};
    }
    {
      unsigned vp[8];
#pragma unroll
      for (int j = 0; j < 8; ++j) vp[j] = (unsigned)vv[2 * j] | ((unsigned)vv[2 * j + 1] << 16);
      u16* dst = PA + (size_t)(row0 + (d >> 1)) * 2560 + 1536 + h * 128 + (d & 1) * 64 + sq * 16;
      *(uint4*)dst = uint4{vp[0], vp[1], vp[2], vp[3]};
      *(uint4*)(dst + 8) = uint4{vp[4], vp[5], vp[6], vp[7]};
      u16* ld = sVT + d * 72 + sq * 16;
      *(uint4*)ld = uint4{vp[0], vp[1], vp[2], vp[3]};
      *(uint4*)(ld + 8) = uint4{vp[4], vp[5], vp[6], vp[7]};
    }
    __syncthreads();
    {
      const int dir = w >> 2, tt = w & 3;
      const u16* sQ = dir ? sQB : sQF;
      const u16* sK = dir ? sKB : sKF;
      const int fr = lane & 15, fq = lane >> 4;
      bf16x8 a[4];
#pragma unroll
      for (int ks = 0; ks < 4; ++ks) a[ks] = *(const bf16x8*)(sQ + (tt * 16 + fr) * 136 + ks * 32 + fq * 8);
#pragma unroll
      for (int st = 0; st < 4; ++st) {
        f32x4 c = {0.f, 0.f, 0.f, 0.f};
#pragma unroll
        for (int ks = 0; ks < 4; ++ks) {
          bf16x8 b = *(const bf16x8*)(sK + (st * 16 + fr) * 136 + ks * 32 + fq * 8);
          c = __builtin_amdgcn_mfma_f32_16x16x32_bf16(a[ks], b, c, 0, 0, 0);
        }
        const int s = st * 16 + fr;
#pragma unroll
        for (int i = 0; i < 4; ++i) {
          const int t = tt * 16 + fq * 4 + i;
          bool keep = dir ? (s >= t) : (s <= t);
          sAT[(dir * 64 + t) * 72 + s] = keep ? f2bf(c[i]) : (u16)0;
        }
      }
    }
    __syncthreads();
    {
      const int dir = w >> 2;
      const int fr = lane & 15, fq = lane >> 4;
      u16* OX = dir ? OB : OF;
#pragma unroll
      for (int mi = 0; mi < 2; ++mi) {
        const int mt = (w & 3) * 2 + mi;
        bf16x8 a0 = *(const bf16x8*)(sVT + (mt * 16 + fr) * 72 + fq * 8);
        bf16x8 a1 = *(const bf16x8*)(sVT + (mt * 16 + fr) * 72 + 32 + fq * 8);
#pragma unroll
        for (int nt = 0; nt < 4; ++nt) {
          bf16x8 b0 = *(const bf16x8*)(sAT + (dir * 64 + nt * 16 + fr) * 72 + fq * 8);
          bf16x8 b1 = *(const bf16x8*)(sAT + (dir * 64 + nt * 16 + fr) * 72 + 32 + fq * 8);
          f32x4 c = {0.f, 0.f, 0.f, 0.f};
          c = __builtin_amdgcn_mfma_f32_16x16x32_bf16(a0, b0, c, 0, 0, 0);
          c = __builtin_amdgcn_mfma_f32_16x16x32_bf16(a1, b1, c, 0, 0, 0);
          const int t = nt * 16 + fr, dv = mt * 16 + fq * 4;
          *(uint2*)(OX + (size_t)(row0 + t) * 512 + h * 128 + dv) = uint2{pack2(c[0], c[1]), pack2(c[2], c[3])};
        }
      }
    }
  }
}

struct H2Regs { uint4 qf[4]; uint2 oold; uint4 kt[2]; uint4 vt[2]; float4 dec; };

DI void hgrn_h2(const Params& P, unsigned char* smem) {
  const u16* PA = (const u16*)(P.ws + OFF_BIG);
  const u16* YA = (const u16*)(P.ws + OFF_YA);
  const float* DEC = (const float*)(P.ws + OFF_DEC);
  u16* sS = (u16*)smem;
  const int tid = otid(), lane = tid & 63, w = tid >> 6, fr = lane & 15, fq = lane >> 4;
  for (int it = blockIdx.x; it < 256; it += gridDim.x) {
    const int ds = it & 7, dir = (it >> 3) & 1, h = (it >> 4) & 3, b = it >> 6;
    u16* OX = (u16*)(P.ws + (dir ? OFF_YC : OFF_YB));
    __syncthreads();
    for (int i = tid; i < 16 * 136; i += NTHR) sS[i] = 0;
    f32x4 S = {0.f, 0.f, 0.f, 0.f};
    auto chunk_of = [&](int step) -> int {
      if (step < 4) return 512 + b * 4 + (dir ? 3 - step : step);
      int c = step - 4;
      return b * 128 + (dir ? 127 - c : c);
    };
    auto load = [&](int step, H2Regs& r) {
      const int ch = chunk_of(step), row0 = ch * 64;
      if (w < 4) {
        const int t = w * 16 + fr;
        const u16* qsrc = dir ? (YA + (size_t)(row0 + t) * 512 + h * 128) : (PA + (size_t)(row0 + t) * 2560 + h * 128);
#pragma unroll
        for (int ks = 0; ks < 4; ++ks) r.qf[ks] = *(const uint4*)(qsrc + ks * 32 + fq * 8);
        r.oold = *(const uint2*)(OX + (size_t)(row0 + t) * 512 + h * 128 + ds * 16 + fq * 4);
      }
      const int dd = w * 16 + fr;
      const u16* ksrc = PA + (size_t)(row0 + (dd >> 1)) * 2560 + (dir ? 1024 : 512) + h * 128 + (dd & 1) * 64;
      const int dv = ds * 16 + fr;
      const u16* vsrc = PA + (size_t)(row0 + (dv >> 1)) * 2560 + 1536 + h * 128 + (dv & 1) * 64;
#pragma unroll
      for (int ks = 0; ks < 2; ++ks) {
        r.kt[ks] = *(const uint4*)(ksrc + ks * 32 + fq * 8);
        r.vt[ks] = *(const uint4*)(vsrc + ks * 32 + fq * 8);
      }
      r.dec = *(const float4*)(DEC + ((size_t)(dir * 528 + ch) * 4 + h) * 128 + w * 16 + fq * 4);
    };
    H2Regs cur, nxt;
    load(0, cur);
    __syncthreads();
    for (int step = 0; step < 132; ++step) {
      if (step + 1 < 132) load(step + 1, nxt);
      const int row0 = chunk_of(step) * 64;
      if (w < 4) {
        f32x4 c = {0.f, 0.f, 0.f, 0.f};
#pragma unroll
        for (int ks = 0; ks < 4; ++ks) {
          bf16x8 a = *(const bf16x8*)(sS + fr * 136 + ks * 32 + fq * 8);
          c = __builtin_amdgcn_mfma_f32_16x16x32_bf16(a, __builtin_bit_cast(bf16x8, cur.qf[ks]), c, 0, 0, 0);
        }
        const int t = w * 16 + fr;
        uint2 o;
        o.x = pack2(blo(cur.oold.x) + c[0], bhi(cur.oold.x) + c[1]);
        o.y = pack2(blo(cur.oold.y) + c[2], bhi(cur.oold.y) + c[3]);
        *(uint2*)(OX + (size_t)(row0 + t) * 512 + h * 128 + ds * 16 + fq * 4) = o;
      }
      S[0] *= cur.dec.x; S[1] *= cur.dec.y; S[2] *= cur.dec.z; S[3] *= cur.dec.w;
#pragma unroll
      for (int ks = 0; ks < 2; ++ks)
        S = __builtin_amdgcn_mfma_f32_16x16x32_bf16(__builtin_bit_cast(bf16x8, cur.kt[ks]), __builtin_bit_cast(bf16x8, cur.vt[ks]), S, 0, 0, 0);
      __syncthreads();
      *(uint2*)(sS + fr * 136 + w * 16 + fq * 4) = uint2{pack2(S[0], S[1]), pack2(S[2], S[3])};
      __syncthreads();
      cur = nxt;
    }
  }
}

DI void hgrn_h3(const Params& P, int l, int nrows) {
  const u16* PA = (const u16*)(P.ws + OFF_BIG);
  const u16* OF = (const u16*)(P.ws + OFF_YB);
  const u16* OB = (const u16*)(P.ws + OFF_YC);
  u16* YA = (u16*)(P.ws + OFF_YA);
  const int tid_ = otid(), lane = tid_ & 63, w = tid_ >> 6;
  const float* gain = P.in[12] + l * 128;
  for (int row = blockIdx.x * 8 + w; row < nrows; row += gridDim.x * 8) {
    uint4 a = *(const uint4*)(OF + (size_t)row * 512 + lane * 8);
    uint4 b = *(const uint4*)(OB + (size_t)row * 512 + lane * 8);
    uint4 g = *(const uint4*)(PA + (size_t)row * 2560 + 2048 + lane * 8);
    float o[8] = {blo(a.x) + blo(b.x), bhi(a.x) + bhi(b.x), blo(a.y) + blo(b.y), bhi(a.y) + bhi(b.y),
                  blo(a.z) + blo(b.z), bhi(a.z) + bhi(b.z), blo(a.w) + blo(b.w), bhi(a.w) + bhi(b.w)};
    float gg[8] = {blo(g.x), bhi(g.x), blo(g.y), bhi(g.y), blo(g.z), bhi(g.z), blo(g.w), bhi(g.w)};
    float ss = 0.f;
    for (int j = 0; j < 8; ++j) ss += o[j] * o[j];
    ss = row16_sum(ss);
    float rstd = rsqrtf(ss * (1.f / 128.f) + 1e-6f);
    const int dv0 = (lane & 15) * 8;
    float y[8];
    for (int j = 0; j < 8; ++j) y[j] = o[j] * rstd * gain[dv0 + j] * siluf(gg[j]);
    *(uint4*)(YA + (size_t)row * 512 + lane * 8) = uint4{pack2(y[0], y[1]), pack2(y[2], y[3]), pack2(y[4], y[5]), pack2(y[6], y[7])};
  }
}

DI float2 cmul(float2 a, float2 b) { return float2{a.x * b.x - a.y * b.y, a.x * b.y + a.y * b.x}; }

DI float2 twd(const float2* TQ, int k) {
  const bool lowq = k <= 2048;
  const float2 e = TQ[lowq ? k : 4096 - k];
  return lowq ? float2{e.x, -e.y} : float2{e.y, -e.x};
}

DI int ph(int i) { return i + (i >> 7); }

DI void bfly_fwd(float2& a0, float2& a1, float2& a2, float2& a3, float2 w1) {
  float2 w2 = cmul(w1, w1);
  float2 b0 = {a0.x + a2.x, a0.y + a2.y};
  float2 b2 = cmul(float2{a0.x - a2.x, a0.y - a2.y}, w1);
  float2 b1 = {a1.x + a3.x, a1.y + a3.y};
  float2 d3 = {a1.x - a3.x, a1.y - a3.y};
  float2 b3 = cmul(float2{d3.y, -d3.x}, w1);
  a0 = float2{b0.x + b1.x, b0.y + b1.y};
  a1 = cmul(float2{b0.x - b1.x, b0.y - b1.y}, w2);
  a2 = float2{b2.x + b3.x, b2.y + b3.y};
  a3 = cmul(float2{b2.x - b3.x, b2.y - b3.y}, w2);
}
DI void bfly_inv(float2& a0, float2& a1, float2& a2, float2& a3, float2 w1) {
  float2 w2 = cmul(w1, w1);
  float2 t = cmul(a1, w2);
  float2 b0 = {a0.x + t.x, a0.y + t.y}, b1 = {a0.x - t.x, a0.y - t.y};
  t = cmul(a3, w2);
  float2 b2 = {a2.x + t.x, a2.y + t.y}, b3 = {a2.x - t.x, a2.y - t.y};
  t = cmul(b2, w1);
  a0 = float2{b0.x + t.x, b0.y + t.y};
  a2 = float2{b0.x - t.x, b0.y - t.y};
  float2 u = cmul(b3, w1);
  t = float2{-u.y, u.x};
  a1 = float2{b1.x + t.x, b1.y + t.y};
  a3 = float2{b1.x - t.x, b1.y - t.y};
}

template <bool INV, int LH>
DI void fft_pass(float2* X, const float2* __restrict__ TW, int tid) {
  constexpr int h = 1 << LH, hh = h >> 1;
  asm volatile("" : "+v"(tid));
  int p0[8], lo[8];
  float2 a0[8], a1[8], a2[8], a3[8], w1[8];
#pragma unroll
  for (int k = 0; k < 8; ++k) {
    const int q = tid + k * NTHR;
    if (LH >= 7) {
      lo[k] = q & (hh - 1);
      const int hi = q >> (LH - 1);
      p0[k] = (hi << (LH + 1)) + lo[k];
    } else {
      const int r = q & 127, bidx = q >> 7;
      lo[k] = bidx & (hh - 1);
      const int hi = bidx >> (LH - 1);
      p0[k] = r * 129 + (hi << (LH + 1)) + lo[k];
    }
    w1[k] = twd(TW, lo[k] << (13 - LH));
  }
#pragma unroll
  for (int k = 0; k < 8; ++k) {
    if (LH >= 7) {
      const int i0 = p0[k];
      a0[k] = X[ph(i0)]; a1[k] = X[ph(i0 + hh)]; a2[k] = X[ph(i0 + h)]; a3[k] = X[ph(i0 + h + hh)];
    } else {
      a0[k] = X[p0[k]]; a1[k] = X[p0[k] + hh]; a2[k] = X[p0[k] + h]; a3[k] = X[p0[k] + h + hh];
    }
  }
#pragma unroll
  for (int k = 0; k < 8; ++k) {
    float2 w = w1[k];
    if (INV) { w.y = -w.y; bfly_inv(a0[k], a1[k], a2[k], a3[k], w); }
    else bfly_fwd(a0[k], a1[k], a2[k], a3[k], w);
    if (LH >= 7) {
      const int i0 = p0[k];
      X[ph(i0)] = a0[k]; X[ph(i0 + hh)] = a1[k]; X[ph(i0 + h)] = a2[k]; X[ph(i0 + h + hh)] = a3[k];
    } else {
      X[p0[k]] = a0[k]; X[p0[k] + hh] = a1[k]; X[p0[k] + h] = a2[k]; X[p0[k] + h + hh] = a3[k];
    }
  }
  __syncthreads();
}

DI void fft_fwd(float2* X, const float2* __restrict__ TW) {
  const int tid = otid();
  fft_pass<false, 13>(X, TW, tid); fft_pass<false, 11>(X, TW, tid); fft_pass<false, 9>(X, TW, tid); fft_pass<false, 7>(X, TW, tid);
  fft_pass<false, 5>(X, TW, tid); fft_pass<false, 3>(X, TW, tid); fft_pass<false, 1>(X, TW, tid);
}
DI void fft_inv(float2* X, const float2* __restrict__ TW) {
  const int tid = otid();
  fft_pass<true, 1>(X, TW, tid); fft_pass<true, 3>(X, TW, tid); fft_pass<true, 5>(X, TW, tid); fft_pass<true, 7>(X, TW, tid);
  fft_pass<true, 9>(X, TW, tid); fft_pass<true, 11>(X, TW, tid); fft_pass<true, 13>(X, TW, tid);
}

DI float hy_delta(int c) {
  const float mn = -3.0701134573253945f, mx = -15.350567286626973f;
  return fabsf(mn + (mx - mn) * ((float)c / 511.f));
}

DI float conv3_at(const u16* seq, int t, int L, float w0, float w1, float w2, float bias) {
  float c = bf2f(seq[t]);
  float a = t > 0 ? bf2f(seq[t - 1]) : 0.f;
  float b = t < L - 1 ? bf2f(seq[t + 1]) : 0.f;
  return a * w0 + c * w1 + b * w2 + bias;
}

DI void hyena_phase(const Params& P, int l, unsigned char* smem) {
  float2* X = (float2*)smem;
  float* ex = (float*)(smem + 132096);
  const u16* PB = (const u16*)(P.ws + OFF_BIG);
  u16* YB = (u16*)(P.ws + OFF_YB);
  const u16* HID = (const u16*)(P.ws + OFF_HID3);
  const float2* TWG = (const float2*)(P.ws + OFF_TW);
  float2* TWL = (float2*)(smem + 134144);
  const float2* TW = TWL;
  float2* FS = (float2*)(P.ws + OFF_BIG + BIG_FSCR) + (size_t)blockIdx.x * 40960;
  const float* w4 = P.in[21] + (size_t)l * 64 * 2048;
  const float* cw = P.in[13] + l * 3 * 1536;
  const float* cb = P.in[14] + l * 1536;
  const int tid = otid();
  __syncthreads();
  for (int k = tid; k <= 2048; k += NTHR) { float2 e = TWG[k]; TWL[k] = float2{e.x, -e.y}; }
  __syncthreads();
  for (int it = blockIdx.x; it < 512; it += gridDim.x) {
    const int xcd = it & 7, j = (it >> 3) & 31, grp = (it >> 8) * 8 + xcd;
    const int c = grp * 32 + j;
    __syncthreads();
    if (tid < 256) { int f = tid & 63, wh = tid >> 6; ex[tid] = w4[f * 2048 + (wh >> 1) * 1024 + (wh & 1) * 512 + c]; }
    __syncthreads();
    const float delta = hy_delta(c);
    float n0 = 0.f, n1 = 0.f;
    {
      const int lane = tid & 63, wv = tid >> 6, fr = lane & 15, fq = lane >> 4;
      bf16x8 wa0, wa1;
      {
        unsigned t0[4], t1[4];
#pragma unroll
        for (int j = 0; j < 4; ++j) {
          const float a0 = fr < 4 ? ex[fr * 64 + fq * 8 + 2 * j] : 0.f, a1 = fr < 4 ? ex[fr * 64 + fq * 8 + 2 * j + 1] : 0.f;
          const float c0 = fr < 4 ? ex[fr * 64 + 32 + fq * 8 + 2 * j] : 0.f, c1 = fr < 4 ? ex[fr * 64 + 32 + fq * 8 + 2 * j + 1] : 0.f;
          t0[j] = pack2(a0, a1); t1[j] = pack2(c0, c1);
        }
        wa0 = __builtin_bit_cast(bf16x8, uint4{t0[0], t0[1], t0[2], t0[3]});
        wa1 = __builtin_bit_cast(bf16x8, uint4{t1[0], t1[1], t1[2], t1[3]});
      }
#pragma unroll 4
      for (int g = wv; g < 1024; g += 8) {
        const int n = g * 16 + fr;
        const int dir = n > 8192 ? 1 : 0;
        const int pos = dir ? 16384 - n : n;
        const uint4* hp = (const uint4*)(HID + (size_t)pos * 64 + fq * 8);
        const bf16x8 b0 = __builtin_bit_cast(bf16x8, hp[0]);
        const bf16x8 b1 = __builtin_bit_cast(bf16x8, hp[4]);
        f32x4 d = {0.f, 0.f, 0.f, 0.f};
        d = __builtin_amdgcn_mfma_f32_16x16x32_bf16(wa0, b0, d, 0, 0, 0);
        d = __builtin_amdgcn_mfma_f32_16x16x32_bf16(wa1, b1, d, 0, 0, 0);
        if (fq == 0) {
          float k0 = dir ? d[2] : d[0], k1 = dir ? d[3] : d[1];
          const float win = __expf(-((float)pos / 8191.f) * delta) + 0.05f;
          k0 *= win; k1 *= win;
          if (n == 8192) { k0 = 0.f; k1 = 0.f; }
          n0 += fabsf(k0); n1 += fabsf(k1);
          X[ph(n)] = float2{k0, k1};
        }
      }
    }
    const float norm0 = block_sum(n0, ex + 256), norm1 = block_sum(n1, ex + 272);
    __syncthreads();
    fft_fwd(X, TW);
    {
      const float s0 = 1.f / (norm0 * 16384.f), s1 = 1.f / (norm1 * 16384.f);
#pragma unroll 4
      for (int p = tid; p < 16384; p += NTHR) {
        const int f = (int)(__brev((unsigned)p) >> 18);
        const int p2 = (int)(__brev((unsigned)((16384 - f) & 16383)) >> 18);
        float2 a = X[ph(p)], b = X[ph(p2)];
        FS[p] = float2{(a.x + b.x) * 0.5f * s0, (a.y - b.y) * 0.5f * s0};
        FS[16384 + p] = float2{(a.y + b.y) * 0.5f * s1, -(a.x - b.x) * 0.5f * s1};
      }
    }
    const float cwz0 = cw[1024 + c], cwz1 = cw[1536 + 1024 + c], cwz2 = cw[3072 + 1024 + c], cbz = cb[1024 + c];
    float2* VS = FS + 32768;
    for (int bp = 0; bp < 2; ++bp) {
      const int rb0 = (2 * bp) * 8192, rb1 = rb0 + 8192;
      const u16* z0 = PB + ((size_t)((2 * bp) * 1536 + 1024 + c) << 13);
      const u16* z1 = PB + ((size_t)((2 * bp + 1) * 1536 + 1024 + c) << 13);
#pragma unroll 1
      for (int o = 0; o < 2; ++o) {
        int tl = tid; asm volatile("" : "+v"(tl));
        __syncthreads();
#pragma unroll
        for (int kb = 0; kb < 8; kb += 4) {
          asm volatile("" : "+v"(tl));
          float2 a0[4], a1[4], w1[4];
#pragma unroll
          for (int k = 0; k < 4; ++k) {
            const int q = tl + (kb + k) * NTHR;
            if (o == 0) {
              a0[k].x = conv3_at(z0, q, 8192, cwz0, cwz1, cwz2, cbz);
              a0[k].y = conv3_at(z1, q, 8192, cwz0, cwz1, cwz2, cbz);
              a1[k].x = conv3_at(z0, q + 4096, 8192, cwz0, cwz1, cwz2, cbz);
              a1[k].y = conv3_at(z1, q + 4096, 8192, cwz0, cwz1, cwz2, cbz);
              VS[q] = a0[k]; VS[q + 4096] = a1[k];
            } else { a0[k] = VS[q]; a1[k] = VS[q + 4096]; }
            w1[k] = twd(TW, q);
          }
#pragma unroll
          for (int k = 0; k < 4; ++k) {
            const int q = tl + (kb + k) * NTHR;
            float2 a2 = {0.f, 0.f}, a3 = {0.f, 0.f};
            bfly_fwd(a0[k], a1[k], a2, a3, w1[k]);
            X[ph(q)] = a0[k]; X[ph(q + 4096)] = a1[k]; X[ph(q + 8192)] = a2; X[ph(q + 12288)] = a3;
          }
        }
        __syncthreads();
        fft_pass<false, 11>(X, TW, tl); fft_pass<false, 9>(X, TW, tl); fft_pass<false, 7>(X, TW, tl);
        fft_pass<false, 5>(X, TW, tl); fft_pass<false, 3>(X, TW, tl);
        {
          const float2* Ks = FS + o * 16384;
#pragma unroll
          for (int kb = 0; kb < 8; kb += 4) {
            asm volatile("" : "+v"(tl));
            float2 e0[4], e1[4], e2[4], e3[4];
            float4 kA[4], kB[4];
#pragma unroll
            for (int k = 0; k < 4; ++k) {
              const int q = tl + (kb + k) * NTHR;
              const int r = q & 127, bidx = q >> 7;
              const int p0 = r * 129 + bidx * 4;
              e0[k] = X[p0]; e1[k] = X[p0 + 1]; e2[k] = X[p0 + 2]; e3[k] = X[p0 + 3];
              const float4* kp = (const float4*)(Ks + r * 128 + bidx * 4);
              kA[k] = kp[0]; kB[k] = kp[1];
            }
#pragma unroll
            for (int k = 0; k < 4; ++k) {
              const int q = tl + (kb + k) * NTHR;
              const int r = q & 127, bidx = q >> 7;
              const int p0 = r * 129 + bidx * 4;
              const float2 one = {1.f, 0.f};
              bfly_fwd(e0[k], e1[k], e2[k], e3[k], one);
              e0[k] = cmul(e0[k], float2{kA[k].x, kA[k].y}); e1[k] = cmul(e1[k], float2{kA[k].z, kA[k].w});
              e2[k] = cmul(e2[k], float2{kB[k].x, kB[k].y}); e3[k] = cmul(e3[k], float2{kB[k].z, kB[k].w});
              bfly_inv(e0[k], e1[k], e2[k], e3[k], one);
              X[p0] = e0[k]; X[p0 + 1] = e1[k]; X[p0 + 2] = e2[k]; X[p0 + 3] = e3[k];
            }
          }
          __syncthreads();
        }
        fft_pass<true, 3>(X, TW, tl); fft_pass<true, 5>(X, TW, tl); fft_pass<true, 7>(X, TW, tl);
        fft_pass<true, 9>(X, TW, tl); fft_pass<true, 11>(X, TW, tl);
        const int gc = o * 512 + c;
        const float g0 = cw[gc], g1 = cw[1536 + gc], g2 = cw[3072 + gc], gbias = cb[gc];
        const float skip = P.in[23][(l * 2 + o) * 512 + c];
        const u16* x0p = PB + ((size_t)((2 * bp) * 1536 + gc) << 13);
        const u16* x1p = PB + ((size_t)((2 * bp + 1) * 1536 + gc) << 13);
#pragma unroll
        for (int kb = 0; kb < 8; kb += 4) {
          asm volatile("" : "+v"(tl));
          float2 a0[4], a1[4], a2[4], a3[4], w1[4], vo0[4], vo1[4];
          float xa[4], xb[4], xc2[4], xd[4];
#pragma unroll
          for (int k = 0; k < 4; ++k) {
            const int q = tl + (kb + k) * NTHR;
            a0[k] = X[ph(q)]; a1[k] = X[ph(q + 4096)]; a2[k] = X[ph(q + 8192)]; a3[k] = X[ph(q + 12288)];
            w1[k] = twd(TW, q); w1[k].y = -w1[k].y;
            vo0[k] = VS[q]; vo1[k] = VS[q + 4096];
            xa[k] = conv3_at(x0p, q, 8192, g0, g1, g2, gbias);
            xb[k] = conv3_at(x1p, q, 8192, g0, g1, g2, gbias);
            xc2[k] = conv3_at(x0p, q + 4096, 8192, g0, g1, g2, gbias);
            xd[k] = conv3_at(x1p, q + 4096, 8192, g0, g1, g2, gbias);
          }
#pragma unroll
          for (int k = 0; k < 4; ++k) {
            const int q = tl + (kb + k) * NTHR;
            bfly_inv(a0[k], a1[k], a2[k], a3[k], w1[k]);
            float2 n0v, n1v;
            n0v.x = xa[k] * (a0[k].x + vo0[k].x * skip);
            n0v.y = xb[k] * (a0[k].y + vo0[k].y * skip);
            n1v.x = xc2[k] * (a1[k].x + vo1[k].x * skip);
            n1v.y = xd[k] * (a1[k].y + vo1[k].y * skip);
            if (o == 0) { VS[q] = n0v; VS[q + 4096] = n1v; }
            else {
              YB[(size_t)(rb0 + q) * 512 + c] = f2bf(n0v.x);
              YB[(size_t)(rb1 + q) * 512 + c] = f2bf(n0v.y);
              YB[(size_t)(rb0 + q + 4096) * 512 + c] = f2bf(n1v.x);
              YB[(size_t)(rb1 + q + 4096) * 512 + c] = f2bf(n1v.y);
            }
          }
        }
      }
    }
  }
}

DI void hyena_ctx_phase(const Params& P, int l, unsigned char* smem) {
  float* kf = (float*)smem;
  float* vz = kf + 1024;
  float* red = vz + 1024;
  const u16* PBC = (const u16*)(P.ws + OFF_BIG) + (size_t)4 * 1536 * 8192;
  u16* YB = (u16*)(P.ws + OFF_YB);
  const u16* HID = (const u16*)(P.ws + OFF_HID3) + (size_t)8192 * 64;
  const float* w4 = P.in[21] + (size_t)l * 64 * 2048;
  const float* cw = P.in[13] + l * 3 * 1536;
  const float* cb = P.in[14] + l * 1536;
  const int tid = otid();
  for (int c = blockIdx.x; c < 512; c += gridDim.x) {
    const float delta = hy_delta(c);
    __syncthreads();
    float n0 = 0.f, n1 = 0.f;
    for (int idx = tid; idx < 1024; idx += NTHR) {
      const int pos = idx & 255, wh = idx >> 8, dir = wh >> 1, o = wh & 1;
      float a = 0.f;
      for (int f = 0; f < 64; ++f) a += bf2f(HID[pos * 64 + f]) * w4[f * 2048 + dir * 1024 + o * 512 + c];
      a *= __expf(-((float)pos / 255.f) * delta) + 0.05f;
      kf[idx] = a;
      if (!(dir == 1 && pos == 0)) { if (o == 0) n0 += fabsf(a); else n1 += fabsf(a); }
    }
    const float norm0 = block_sum(n0, red), norm1 = block_sum(n1, red + 16);
    float vreg[2];
    for (int r = 0; r < 2; ++r) {
      const int idx = tid + r * 512, b = idx >> 8, t = idx & 255;
      vreg[r] = conv3_at(PBC + ((size_t)(b * 1536 + 1024 + c) << 8), t, 256, cw[1024 + c], cw[1536 + 1024 + c], cw[3072 + 1024 + c], cb[1024 + c]);
    }
    for (int o = 0; o < 2; ++o) {
      __syncthreads();
      for (int r = 0; r < 2; ++r) vz[tid + r * 512] = vreg[r];
      __syncthreads();
      const float inv = 1.f / (o == 0 ? norm0 : norm1);
      const int gc = o * 512 + c;
      const float skip = P.in[23][(l * 2 + o) * 512 + c];
      for (int r = 0; r < 2; ++r) {
        const int idx = tid + r * 512, b = idx >> 8, t = idx & 255;
        float y = 0.f;
        for (int s = 0; s < 256; ++s) {
          const int lag = t - s;
          float kk = lag >= 0 ? kf[(0 * 2 + o) * 256 + lag] : kf[(1 * 2 + o) * 256 - lag];
          y += kk * vz[b * 256 + s];
        }
        y *= inv;
        float xg = conv3_at(PBC + ((size_t)(b * 1536 + gc) << 8), t, 256, cw[gc], cw[1536 + gc], cw[3072 + gc], cb[gc]);
        vreg[r] = xg * (y + vreg[r] * skip);
      }
    }
    for (int r = 0; r < 2; ++r) {
      const int idx = tid + r * 512, b = idx >> 8, t = idx & 255;
      YB[(size_t)(RL + b * 256 + t) * 512 + c] = f2bf(vreg[r]);
    }
  }
}

DI float rope_inv(int i) { return exp2f(-(float)(2 * i) * (13.287712379549449f / 32.f)); }

DI float axial_rope_lane(float x, int lane, int t) {
  const int sec = lane >> 5, jj = lane & 31, i = jj & 15;
  const float posc = sec ? (float)(t & 63) : (float)(t >> 6);
  float sn, cs;
  sincosf(posc * rope_inv(i), &sn, &cs);
  float partner = shx(x, 16, lane);
  return (jj < 16) ? (x * cs - partner * sn) : (x * cs + partner * sn);
}

DI void mla_e1(const Params& P, int l) {
  u16* PC = (u16*)(P.ws + OFF_BIG);
  const int tid_ = otid(), lane = tid_ & 63, w = tid_ >> 6;
  const float* qan = P.in[24] + l * 256; const float* kvn = P.in[26] + l * 128; const float* krn = P.in[31] + l * 64;
  for (int row = blockIdx.x * 8 + w; row < RA; row += gridDim.x * 8) {
    u16* pr = PC + (size_t)row * 448;
    uint2 qa = *(const uint2*)(pr + lane * 4);
    unsigned kv = *(const unsigned*)(pr + 256 + lane * 2);
    float kr = bf2f(pr[384 + lane]);
    float q0 = blo(qa.x), q1 = bhi(qa.x), q2 = blo(qa.y), q3 = bhi(qa.y);
    float ssq = wave_sum(q0 * q0 + q1 * q1 + q2 * q2 + q3 * q3, lane);
    float rq = rsqrtf(ssq * (1.f / 256.f) + 1e-6f);
    float k0 = blo(kv), k1 = bhi(kv);
    float ssk = wave_sum(k0 * k0 + k1 * k1, lane);
    float rk = rsqrtf(ssk * (1.f / 128.f) + 1e-6f);
    float ssr = wave_sum(kr * kr, lane);
    float rr = rsqrtf(ssr * (1.f / 64.f) + 1e-6f);
    *(uint2*)(pr + lane * 4) = uint2{pack2(q0 * rq * qan[lane * 4], q1 * rq * qan[lane * 4 + 1]), pack2(q2 * rq * qan[lane * 4 + 2], q3 * rq * qan[lane * 4 + 3])};
    *(unsigned*)(pr + 256 + lane * 2) = pack2(k0 * rk * kvn[lane * 2], k1 * rk * kvn[lane * 2 + 1]);
    float x = kr * rr * krn[lane];
    if (row < RL) x = axial_rope_lane(x, lane, row & 8191);
    pr[384 + lane] = f2bf(x);
  }
}

DI void mla_e2(const Params& P, int l) {
  const u16* PC = (const u16*)(P.ws + OFF_BIG);
  u16* Q = (u16*)(P.ws + OFF_BIG + BIG_Q);
  u16* K = (u16*)(P.ws + OFF_BIG + BIG_K);
  const int tid_ = otid(), lane = tid_ & 63, w = tid_ >> 6;
  const float* qnn = P.in[28] + l * 128; const float* qrn = P.in[29] + l * 64; const float* knn = P.in[30] + l * 128;
  const float qscale = 0.07216878364870322f * 1.4426950408889634f;
  for (int row = blockIdx.x * 8 + w; row < RA; row += gridDim.x * 8) {
    u16 krr = PC[(size_t)row * 448 + 384 + lane];
    for (int h = 0; h < 4; ++h) {
      u16* qp = Q + (size_t)row * 768 + h * 192;
      unsigned qn = *(const unsigned*)(qp + lane * 2);
      float qr = bf2f(qp[128 + lane]);
      float a0 = blo(qn), a1 = bhi(qn);
      float r1 = rsqrtf(wave_sum(a0 * a0 + a1 * a1, lane) * (1.f / 128.f) + 1e-6f);
      float r2 = rsqrtf(wave_sum(qr * qr, lane) * (1.f / 64.f) + 1e-6f);
      *(unsigned*)(qp + lane * 2) = pack2(a0 * r1 * qnn[lane * 2] * qscale, a1 * r1 * qnn[lane * 2 + 1] * qscale);
      float x = qr * r2 * qrn[lane];
      if (row < RL) x = axial_rope_lane(x, lane, row & 8191);
      qp[128 + lane] = f2bf(x * qscale);
      u16* kp = K + (size_t)row * 768 + h * 192;
      unsigned kn = *(const unsigned*)(kp + lane * 2);
      float b0 = blo(kn), b1 = bhi(kn);
      float r3 = rsqrtf(wave_sum(b0 * b0 + b1 * b1, lane) * (1.f / 128.f) + 1e-6f);
      *(unsigned*)(kp + lane * 2) = pack2(b0 * r3 * knn[lane * 2], b1 * r3 * knn[lane * 2 + 1]);
      kp[128 + lane] = krr;
    }
  }
}

DI void attn_phase(const Params& P, bool with_ctx_queries, unsigned char* smem) {
  const u16* Q = (const u16*)(P.ws + OFF_BIG + BIG_Q);
  const u16* K = (const u16*)(P.ws + OFF_BIG + BIG_K);
  const u16* VT = (const u16*)(P.ws + OFF_BIG + BIG_VT);
  u16* YC = (u16*)(P.ws + OFF_YC);
  const int tid = otid(), lane = tid & 63, w = tid >> 6, ql = lane & 31, half = lane >> 5;
  const int nitems = 512 + (with_ctx_queries ? 16 : 0);
  for (int it = blockIdx.x; it < nitems; it += gridDim.x) {
    int b, h, qrow0, kt0;
    if (it < 512) { b = it >> 7; h = (it >> 5) & 3; qrow0 = b * 8192 + (it & 31) * 256; kt0 = 0; }
    else { int i2 = it - 512; b = i2 >> 2; h = i2 & 3; qrow0 = RL + b * 256; kt0 = 128; }
    const int qrow = qrow0 + w * 32 + ql;
    bf16x8 qf[12];
    {
      const u16* qp = Q + (size_t)qrow * 768 + h * 192 + half * 8;
#pragma unroll
      for (int ks = 0; ks < 12; ++ks) qf[ks] = *(const bf16x8*)(qp + ks * 16);
    }
    f32x16 O[4];
#pragma unroll
    for (int dt = 0; dt < 4; ++dt)
#pragma unroll
      for (int i = 0; i < 16; ++i) O[dt][i] = 0.f;
    float m_run = -1e30f, l_run = 0.f;
    uint4 pre0, pre1, pre2, pre3, pre4;
#define ATT_GLOAD(KT) do { const int kt_ = (KT); \
      const int krow0 = kt_ < 128 ? b * 8192 + kt_ * 64 : RL + b * 256 + (kt_ - 128) * 64; \
      const u16* kp_ = K + (size_t)(krow0 + (tid >> 3)) * 768 + h * 192 + (tid & 7) * 8; \
      pre0 = *(const uint4*)(kp_); pre1 = *(const uint4*)(kp_ + 64); pre2 = *(const uint4*)(kp_ + 128); \
      const u16* vb_ = VT + ((size_t)(b * 132 + kt_) * 4 + h) * 8192 + tid * 16; \
      pre3 = *(const uint4*)(vb_); pre4 = *(const uint4*)(vb_ + 8); } while (0)
#define ATT_SSTORE(BUF) do { unsigned char* kb_ = smem + (BUF) * 43008 + (tid >> 3) * 400 + (tid & 7) * 16; \
      *(uint4*)(kb_) = pre0; *(uint4*)(kb_ + 128) = pre1; *(uint4*)(kb_ + 256) = pre2; \
      unsigned char* vb2_ = smem + (BUF) * 43008 + 25600 + (tid >> 2) * 136 + (tid & 3) * 32; \
      *(uint4*)(vb2_) = pre3; *(uint4*)(vb2_ + 16) = pre4; } while (0)
    __syncthreads();
    ATT_GLOAD(kt0); ATT_SSTORE(0);
    __syncthreads();
    for (int kt = kt0; kt < 132; ++kt) {
      const bool more = kt + 1 < 132;
      if (more) ATT_GLOAD(kt + 1);
      const unsigned char* kb = smem + ((kt - kt0) & 1) * 43008;
      const unsigned char* vb = kb + 25600;
      f32x16 S[2];
#pragma unroll
      for (int mt = 0; mt < 2; ++mt)
#pragma unroll
        for (int i = 0; i < 16; ++i) S[mt][i] = 0.f;
#define KFRAG(KS, MT) (*(const bf16x8*)(kb + ((MT) * 32 + ql) * 400 + ((KS) * 16 + half * 8) * 2))
      bf16x8 ka0 = KFRAG(0, 0), ka1 = KFRAG(0, 1), kc0, kc1;
      __builtin_amdgcn_sched_barrier(0);
#pragma unroll
      for (int ks = 0; ks < 12; ks += 2) {
        kc0 = KFRAG(ks + 1, 0); kc1 = KFRAG(ks + 1, 1);
        __builtin_amdgcn_sched_barrier(0);
        S[0] = __builtin_amdgcn_mfma_f32_32x32x16_bf16(ka0, qf[ks], S[0], 0, 0, 0);
        S[1] = __builtin_amdgcn_mfma_f32_32x32x16_bf16(ka1, qf[ks], S[1], 0, 0, 0);
        __builtin_amdgcn_sched_barrier(0);
        if (ks + 2 < 12) { ka0 = KFRAG(ks + 2, 0); ka1 = KFRAG(ks + 2, 1); }
        __builtin_amdgcn_sched_barrier(0);
        S[0] = __builtin_amdgcn_mfma_f32_32x32x16_bf16(kc0, qf[ks + 1], S[0], 0, 0, 0);
        S[1] = __builtin_amdgcn_mfma_f32_32x32x16_bf16(kc1, qf[ks + 1], S[1], 0, 0, 0);
        __builtin_amdgcn_sched_barrier(0);
      }
#undef KFRAG
      float mx = S[0][0];
#pragma unroll
      for (int i = 1; i < 16; ++i) mx = fmaxf(mx, S[0][i]);
#pragma unroll
      for (int i = 0; i < 16; ++i) mx = fmaxf(mx, S[1][i]);
      mx = fmaxf(mx, shx(mx, 32, lane));
      const float m_new = fmaxf(m_run, mx);
      const float alpha = __builtin_amdgcn_exp2f(m_run - m_new);
      m_run = m_new;
      float ps = 0.f;
#pragma unroll
      for (int mt = 0; mt < 2; ++mt)
#pragma unroll
        for (int i = 0; i < 16; ++i) { float p = __builtin_amdgcn_exp2f(S[mt][i] - m_new); S[mt][i] = p; ps += p; }
      l_run = l_run * alpha + ps;
      if (__builtin_amdgcn_ballot_w64(alpha != 1.f) != 0) {
#pragma unroll
        for (int dt = 0; dt < 4; ++dt)
#pragma unroll
          for (int i = 0; i < 16; ++i) O[dt][i] *= alpha;
      }
#pragma unroll
      for (int mt = 0; mt < 2; ++mt) {
#pragma unroll
        for (int sp = 0; sp < 2; ++sp) {
          uint4 pk;
          pk.x = pack2(S[mt][8 * sp + 0], S[mt][8 * sp + 1]);
          pk.y = pack2(S[mt][8 * sp + 2], S[mt][8 * sp + 3]);
          pk.z = pack2(S[mt][8 * sp + 4], S[mt][8 * sp + 5]);
          pk.w = pack2(S[mt][8 * sp + 6], S[mt][8 * sp + 7]);
          const bf16x8 pb = __builtin_bit_cast(bf16x8, pk);
          const int k1 = mt * 32 + 16 * sp + 4 * half;
#pragma unroll
          for (int dt = 0; dt < 4; ++dt) {
            const unsigned char* vp = vb + (dt * 32 + ql) * 136 + k1 * 2;
            uint2 lo = *(const uint2*)vp;
            uint2 hi = *(const uint2*)(vp + 16);
            const bf16x8 a = __builtin_bit_cast(bf16x8, uint4{lo.x, lo.y, hi.x, hi.y});
            O[dt] = __builtin_amdgcn_mfma_f32_32x32x16_bf16(a, pb, O[dt], 0, 0, 0);
          }
        }
      }
      if (more) ATT_SSTORE((kt + 1 - kt0) & 1);
      __syncthreads();
    }
    const float lt = l_run + shx(l_run, 32, lane);
    const float inv = 1.f / lt;
    u16* yp = YC + (size_t)qrow * 512 + h * 128;
#pragma unroll
    for (int dt = 0; dt < 4; ++dt)
#pragma unroll
      for (int g = 0; g < 4; ++g) {
        const int dv = dt * 32 + 8 * g + 4 * half;
        *(uint2*)(yp + dv) = uint2{pack2(O[dt][4 * g] * inv, O[dt][4 * g + 1] * inv), pack2(O[dt][4 * g + 2] * inv, O[dt][4 * g + 3] * inv)};
      }
  }
}

DI void ffn_phases(const Params& P, GBar& grid, int l, int f, int nr, unsigned char* smem) {
  u16* WB = (u16*)(P.ws + OFF_WB);
  u16* HB = (u16*)(P.ws + OFF_HB);
  u16* BIG = (u16*)(P.ws + OFF_BIG);
  const u16* W13 = WB + (f == 0 ? W_13A : W_13B);
  const u16* W2 = WB + (f == 0 ? W_2A : W_2B);
  const int gidx = f == 0 ? 2 : 8;
  gemm_phase2(HB, 1024, W13, 1024, 1024, nr, 5632, smem, [&](f32x4 (&acc)[8][4], int rbase, int cbase) {
#pragma unroll
    for (int ct = 0; ct < 8; ct += 2)
#pragma unroll
      for (int tt = 0; tt < 4; ++tt) {
        const int row = rbase + tt * 16;
        const int fq4 = cbase & 12;
        const int j = ((cbase - fq4 + ct * 16) >> 1) + fq4;
        f32x4 a = acc[ct][tt], b = acc[ct + 1][tt];
        *(uint2*)(BIG + (size_t)row * 2816 + j) = uint2{pack2(siluf(a[0]) * b[0], siluf(a[1]) * b[1]), pack2(siluf(a[2]) * b[2], siluf(a[3]) * b[3])};
      }
  });
  grid.sync();
  gemm_phase(BIG, 2816, W2, 2816, 2816, nr, 1024, smem, [&](f32x4 (&acc)[4][4], int rbase, int cbase) {
    float4 g[4];
    const float* mdp = modp(P, l, rbase) + gidx * 1024 + cbase;
#pragma unroll
    for (int ct = 0; ct < 4; ++ct) g[ct] = *(const float4*)(mdp + ct * 16);
#pragma unroll
    for (int tt = 0; tt < 4; ++tt) {
      float4* xp = (float4*)(xrow(P, rbase + tt * 16) + cbase);
      float4 xv[4];
#pragma unroll
      for (int ct = 0; ct < 4; ++ct) xv[ct] = xp[ct * 4];
      __builtin_amdgcn_sched_barrier(0);
#pragma unroll
      for (int ct = 0; ct < 4; ++ct) {
        xv[ct].x += 0.5f * g[ct].x * acc[ct][tt][0]; xv[ct].y += 0.5f * g[ct].y * acc[ct][tt][1];
        xv[ct].z += 0.5f * g[ct].z * acc[ct][tt][2]; xv[ct].w += 0.5f * g[ct].w * acc[ct][tt][3];
      }
#pragma unroll
      for (int ct = 0; ct < 4; ++ct) xp[ct * 4] = xv[ct];
    }
  });
  grid.sync();
}


__global__ void __launch_bounds__(NTHR) fwd_megakernel(Params P) {
  extern __shared__ __attribute__((aligned(16))) unsigned char smem[];
  cg::grid_group cgrid = cg::this_grid();
  GBar grid; grid.bar = (unsigned*)(P.ws + OFF_BAR); grid.post();
  u16* WB = (u16*)(P.ws + OFF_WB);
  u16* HB = (u16*)(P.ws + OFF_HB);
  u16* BIG = (u16*)(P.ws + OFF_BIG);
  u16* YA = (u16*)(P.ws + OFF_YA);
  u16* YB = (u16*)(P.ws + OFF_YB);
  u16* YC = (u16*)(P.ws + OFF_YC);

  mods_phase(P, smem);
  convert_phase(P, 0, smem);
  hid3_phase(P, 0, smem);
  cgrid.sync();
  grid.census();

  for (int l = 0; l < 2; ++l) {
    const int nrows2 = (l == 0) ? RA : RL;
    norm_phase(P, l, 0, RA, l == 0);
    if (l == 1) { convert_phase(P, 1, smem); hid3_phase(P, 1, smem); }
    grid.sync();
    ffn_phases(P, grid, l, 0, RA, smem);
    {

      norm_phase(P, l, 1, RA, false);
      grid.sync();
      gemm_phase2(HB, 1024, WB + W_IN, 1024, 1024, RA, 2560, smem, [&](f32x4 (&acc)[8][4], int rbase, int cbase) {
#pragma unroll
        for (int ct = 0; ct < 8; ++ct)
#pragma unroll
          for (int tt = 0; tt < 4; ++tt) {
            const int row = rbase + tt * 16, col = cbase + ct * 16;
            *(uint2*)(BIG + (size_t)row * 2560 + col) = uint2{pack2(acc[ct][tt][0], acc[ct][tt][1]), pack2(acc[ct][tt][2], acc[ct][tt][3])};
          }
      });
      grid.sync();
      hgrn_h1(P, l, smem);
      grid.sync();
      hgrn_h2(P, smem);
      grid.sync();
      hgrn_h3(P, l, nrows2);
      grid.sync();
      gemm_phase<true>(HB, 1024, WB + W_IN + (size_t)2560 * 1024, 1024, 1024, RA, 1536, smem, [&](f32x4 (&acc)[4][4], int rbase, int cbase) {
#pragma unroll
        for (int ct = 0; ct < 4; ++ct)
#pragma unroll
          for (int tt = 0; tt < 4; ++tt) {
            const int row = rbase + tt * 16, col = cbase + ct * 16;
            u16* dst = row < RL ? BIG + ((size_t)((row >> 13) * 1536 + col) << 13) + (row & 8191)
                                : BIG + (size_t)4 * 1536 * 8192 + ((size_t)(((row - RL) >> 8) * 1536 + col) << 8) + (row & 255);
            *(uint2*)dst = uint2{pack2(acc[ct][tt][0], acc[ct][tt][1]), pack2(acc[ct][tt][2], acc[ct][tt][3])};
          }
      });
      grid.sync();
      hyena_phase(P, l, smem);
      if (l == 0) hyena_ctx_phase(P, l, smem);
      grid.sync();
      gemm_phase(HB, 1024, WB + W_IN + (size_t)4096 * 1024, 1024, 1024, RA, 448, smem, [&](f32x4 (&acc)[4][4], int rbase, int cbase) {
#pragma unroll
        for (int ct = 0; ct < 4; ++ct)
#pragma unroll
          for (int tt = 0; tt < 4; ++tt) {
            const int row = rbase + tt * 16, col = cbase + ct * 16;
            if (col < 448) *(uint2*)(BIG + (size_t)row * 448 + col) = uint2{pack2(acc[ct][tt][0], acc[ct][tt][1]), pack2(acc[ct][tt][2], acc[ct][tt][3])};
          }
      });
      grid.sync();
      mla_e1(P, l);
      grid.sync();
      {
        u16* Qb = (u16*)(P.ws + OFF_BIG + BIG_Q);
        u16* Kb = (u16*)(P.ws + OFF_BIG + BIG_K);
        u16* Vb = (u16*)(P.ws + OFF_BIG + BIG_VT);
        gemm_phase(BIG, 448, WB + W_UQ, 256, 256, RA, 768, smem, [&](f32x4 (&acc)[4][4], int rbase, int cbase) {
#pragma unroll
          for (int ct = 0; ct < 4; ++ct)
#pragma unroll
            for (int tt = 0; tt < 4; ++tt) {
              const int row = rbase + tt * 16, col = cbase + ct * 16;
              *(uint2*)(Qb + (size_t)row * 768 + col) = uint2{pack2(acc[ct][tt][0], acc[ct][tt][1]), pack2(acc[ct][tt][2], acc[ct][tt][3])};
            }
        });
        gemm_phase(BIG + 256, 448, WB + W_UKV, 128, 128, RA, 512, smem, [&](f32x4 (&acc)[4][4], int rbase, int cbase) {
#pragma unroll
          for (int ct = 0; ct < 4; ++ct)
#pragma unroll
            for (int tt = 0; tt < 4; ++tt) {
              const int row = rbase + tt * 16, col = cbase + ct * 16;
              const int hh = col >> 8, jj = col & 255;
              *(uint2*)(Kb + (size_t)row * 768 + hh * 192 + jj) = uint2{pack2(acc[ct][tt][0], acc[ct][tt][1]), pack2(acc[ct][tt][2], acc[ct][tt][3])};
            }
        }, 2, 0);
        gemm_phase<true>(BIG + 256, 448, WB + W_UKV, 128, 128, RA, 512, smem, [&](f32x4 (&acc)[4][4], int rbase, int cbase) {
#pragma unroll
          for (int ct = 0; ct < 4; ++ct)
#pragma unroll
            for (int tt = 0; tt < 4; ++tt) {
              const int row = rbase + tt * 16, col = cbase + ct * 16;
              const int hh = col >> 8, dv = (col & 255) - 128;
              int bb, kt;
              if (row < RL) { bb = row >> 13; kt = (row & 8191) >> 6; } else { int rc = row - RL; bb = rc >> 8; kt = 128 + ((rc & 255) >> 6); }
              u16* vp = Vb + (((size_t)(bb * 132 + kt) * 4 + hh) * 128 + dv) * 64 + (row & 63);
              *(uint2*)vp = uint2{pack2(acc[ct][tt][0], acc[ct][tt][1]), pack2(acc[ct][tt][2], acc[ct][tt][3])};
            }
        }, 2, 1);
      }
      grid.sync();
      mla_e2(P, l);
      grid.sync();
      attn_phase(P, l == 0, smem);
      grid.sync();
      gemm_phase2(HB, 1024, WB + W_IN + (size_t)4544 * 1024, 1024, 1024, nrows2, 3072, smem, [&](f32x4 (&acc)[8][4], int rbase, int cbase) {
#pragma unroll
        for (int ct = 0; ct < 8; ++ct)
#pragma unroll
          for (int tt = 0; tt < 4; ++tt) {
            const int row = rbase + tt * 16, col = cbase + ct * 16;
            *(uint2*)(BIG + (size_t)row * 3072 + col) = uint2{pack2(sigmf(acc[ct][tt][0]), sigmf(acc[ct][tt][1])), pack2(sigmf(acc[ct][tt][2]), sigmf(acc[ct][tt][3]))};
          }
      });
      grid.sync();
      {
        const int ntm = nrows2 >> 8;
        const int tid_ = otid(), lane = tid_ & 63, w = tid_ >> 6, wt = w & 3, wc = w >> 2;
        const TileIter ti(ntm, 8);
        for (int i = 0; i < ti.ntot_it; ++i) {
          int rt_, ct_;
          ti.get(i, rt_, ct_);
          const int row0 = rt_ * 256, col0 = ct_ * 128;
          const int rbase = row0 + wt * 64 + (lane & 15), cbase = col0 + wc * 64 + (lane >> 4) * 4;
          for (int x = 0; x < 3; ++x) {
            f32x4 acc[4][4];
            zero_acc(acc);
            const u16* Yx = x == 0 ? YA : x == 1 ? YB : YC;
            gemm_main(acc, Yx, 512, WB + W_BRA + (size_t)x * 524288, 512, 512, row0, col0, smem);
#pragma unroll
            for (int tt = 0; tt < 4; ++tt) {
              const int row = rbase + tt * 16;
              const u16* gp = BIG + (size_t)row * 3072 + x * 1024 + cbase;
              uint2* mp = (uint2*)(HB + (size_t)row * 1024 + cbase);
              uint2 g[4], o[4];
#pragma unroll
              for (int ct = 0; ct < 4; ++ct) { g[ct] = *(const uint2*)(gp + ct * 16); o[ct] = x > 0 ? mp[ct * 4] : uint2{0u, 0u}; }
              __builtin_amdgcn_sched_barrier(0);
#pragma unroll
              for (int ct = 0; ct < 4; ++ct) {
                const float m0 = blo(g[ct].x) * acc[ct][tt][0] + blo(o[ct].x), m1 = bhi(g[ct].x) * acc[ct][tt][1] + bhi(o[ct].x);
                const float m2 = blo(g[ct].y) * acc[ct][tt][2] + blo(o[ct].y), m3 = bhi(g[ct].y) * acc[ct][tt][3] + bhi(o[ct].y);
                g[ct] = uint2{pack2(m0, m1), pack2(m2, m3)};
              }
#pragma unroll
              for (int ct = 0; ct < 4; ++ct) mp[ct * 4] = g[ct];
            }
          }
        }
      }
      grid.sync();
      gemm_phase(HB, 1024, WB + W_OUT, 1024, 1024, nrows2, 1024, smem, [&](f32x4 (&acc)[4][4], int rbase, int cbase) {
        float4 g[4];
        const float* mdp = modp(P, l, rbase) + 5 * 1024 + cbase;
#pragma unroll
        for (int ct = 0; ct < 4; ++ct) g[ct] = *(const float4*)(mdp + ct * 16);
#pragma unroll
        for (int tt = 0; tt < 4; ++tt) {
          float4* xp = (float4*)(xrow(P, rbase + tt * 16) + cbase);
          float4 xv[4];
#pragma unroll
          for (int ct = 0; ct < 4; ++ct) xv[ct] = xp[ct * 4];
          __builtin_amdgcn_sched_barrier(0);
#pragma unroll
          for (int ct = 0; ct < 4; ++ct) {
            xv[ct].x += g[ct].x * acc[ct][tt][0]; xv[ct].y += g[ct].y * acc[ct][tt][1];
            xv[ct].z += g[ct].z * acc[ct][tt][2]; xv[ct].w += g[ct].w * acc[ct][tt][3];
          }
#pragma unroll
          for (int ct = 0; ct < 4; ++ct) xp[ct * 4] = xv[ct];
        }
      });
      grid.sync();
    }
    norm_phase(P, l, 2, nrows2, false);
    grid.sync();
    ffn_phases(P, grid, l, 1, nrows2, smem);
  }
}

extern "C" void kernel_launch(void* const* d_in, const int* in_sizes, int n_in, void* d_out, int out_size, void* d_ws, size_t ws_size,
                              hipStream_t stream) {
  static int grid_blocks = 0;
  if (!grid_blocks) {
    int dev = 0, cus = 0, per_cu = 0;
    hipGetDevice(&dev);
    hipDeviceGetAttribute(&cus, hipDeviceAttributeMultiprocessorCount, dev);
    hipFuncSetAttribute((const void*)fwd_megakernel, hipFuncAttributeMaxDynamicSharedMemorySize, LDS_BYTES);
    hipOccupancyMaxActiveBlocksPerMultiprocessor(&per_cu, (const void*)fwd_megakernel, NTHR, LDS_BYTES);
    if (per_cu < 1) { fprintf(stderr, "occupancy query says %d blocks/CU\n", per_cu); per_cu = 1; }
    grid_blocks = (cus & ~7);
    if (ws_size < WS_NEED) fprintf(stderr, "workspace too small: %zu < %zu\n", ws_size, (size_t)WS_NEED);
  }
  Params p{};
  for (int i = 0; i < 39; ++i) p.in[i] = (const float*)d_in[i];
  p.out = (float*)d_out;
  p.ws = (unsigned char*)d_ws;
  (void)hipMemsetAsync((unsigned char*)d_ws + OFF_BAR, 0, 16384, stream);
  void* args[] = {&p};
  hipError_t e = hipLaunchCooperativeKernel((const void*)fwd_megakernel, dim3(grid_blocks), dim3(NTHR), args, LDS_BYTES, stream);
  if (e != hipSuccess) fprintf(stderr, "cooperative launch failed: %s (grid %d)\n", hipGetErrorString(e), grid_blocks);
}
```

```cpp
#include <hip/hip_runtime.h>
#include <hip/hip_cooperative_groups.h>
#include <cstdio>
namespace cg = cooperative_groups;

#define DI __device__ __forceinline__
typedef unsigned short u16;
typedef __attribute__((ext_vector_type(8))) short bf16x8;
typedef __attribute__((ext_vector_type(4))) float f32x4;
typedef __attribute__((ext_vector_type(16))) float f32x16;

constexpr int NTHR = 512;
constexpr int RL = 32768, RA = 33792;
constexpr int LDS_BYTES = 151552;

constexpr size_t OFF_MODS = 0;
constexpr size_t OFF_XC   = OFF_MODS + 368640;
constexpr size_t OFF_HID3 = OFF_XC + 4194304;
constexpr size_t OFF_DEC  = OFF_HID3 + 2162688;
constexpr size_t OFF_TW   = OFF_DEC + 2162688;
constexpr size_t OFF_BAR  = OFF_TW + 65536;
constexpr size_t OFF_WB   = OFF_BAR + 16384;
constexpr size_t OFF_HB   = OFF_WB + 56098816;
constexpr size_t OFF_YA   = OFF_HB + 69206016;
constexpr size_t OFF_YB   = OFF_YA + 34603008;
constexpr size_t OFF_YC   = OFF_YB + 34603008;
constexpr size_t OFF_BIG  = OFF_YC + 34603008;
constexpr size_t BIG_FSCR = 104857600;
constexpr size_t BIG_Q    = 30277632;
constexpr size_t BIG_K    = BIG_Q + 51904512;
constexpr size_t BIG_VT   = BIG_K + 51904512;
constexpr size_t WS_NEED  = OFF_BIG + 207618048;
constexpr int W_13A = 0, W_2A = 5767168, W_IN = 8650752, W_UQ = 16449536, W_UKV = 16646144, W_BRA = 16777216,
              W_BRB = 17301504, W_BRC = 17825792, W_OUT = 18350080, W_13B = 19398656, W_2B = 25165824;

struct Params { const float* in[39]; float* out; unsigned char* ws; };

DI int otid() { int t = __builtin_amdgcn_workitem_id_x(); asm volatile("" : "+v"(t)); return t; }
typedef float f32x2_t __attribute__((ext_vector_type(2)));
typedef __bf16 bf16x2_t __attribute__((ext_vector_type(2)));
DI unsigned pack2(float a, float b) { f32x2_t v = {a, b}; bf16x2_t r = __builtin_convertvector(v, bf16x2_t); return __builtin_bit_cast(unsigned, r); }
DI u16 f2bf(float x) { return (u16)(pack2(x, x) & 0xffffu); }
DI float bf2f(u16 h) { return __uint_as_float(((unsigned)h) << 16); }
DI float blo(unsigned u) { return __uint_as_float(u << 16); }
DI float bhi(unsigned u) { return __uint_as_float(u & 0xffff0000u); }
DI float siluf(float x) { return x * __builtin_amdgcn_rcpf(1.f + __expf(-x)); }
DI float sigmf(float x) { return __builtin_amdgcn_rcpf(1.f + __expf(-x)); }
DI float shx(float v, int mask, int lane) { return __int_as_float(__builtin_amdgcn_ds_bpermute((lane ^ mask) << 2, __float_as_int(v))); }
DI float row16_sum(float v) {
  v += __int_as_float(__builtin_amdgcn_update_dpp(0, __float_as_int(v), 0xB1, 0xF, 0xF, true));
  v += __int_as_float(__builtin_amdgcn_update_dpp(0, __float_as_int(v), 0x4E, 0xF, 0xF, true));
  v += __int_as_float(__builtin_amdgcn_update_dpp(0, __float_as_int(v), 0x141, 0xF, 0xF, true));
  v += __int_as_float(__builtin_amdgcn_update_dpp(0, __float_as_int(v), 0x140, 0xF, 0xF, true));
  return v;
}
DI float wave_sum(float v, int lane) {
  (void)lane;
  v = row16_sum(v);
  const int iv = __float_as_int(v);
  return __int_as_float(__builtin_amdgcn_readlane(iv, 0)) + __int_as_float(__builtin_amdgcn_readlane(iv, 16)) +
         __int_as_float(__builtin_amdgcn_readlane(iv, 32)) + __int_as_float(__builtin_amdgcn_readlane(iv, 48));
}
DI float* xrow(const Params& P, int r) { return r < RL ? P.out + (size_t)r * 1024 : (float*)(P.ws + OFF_XC) + (size_t)(r - RL) * 1024; }
DI const float* modp(const Params& P, int l, int r) { int mi = r < RL ? (r >> 13) : 4; return (const float*)(P.ws + OFF_MODS) + (size_t)(l * 5 + mi) * 9216; }
DI float block_sum(float v, float* red) {
  const int t_ = otid();
  v = wave_sum(v, t_ & 63);
  __syncthreads();
  if ((t_ & 63) == 0) red[t_ >> 6] = v;
  __syncthreads();
  float s = 0.f;
  for (int i = 0; i < 8; ++i) s += red[i];
  return s;
}

#define XB_XCNT(j) (256 + 64 * (j))
#define XB_XSUB(j) (1280 + 64 * (j))
#define XB_XGEN(j) (2304 + 64 * (j))
#define XB_TOP 3328
#define XB_TOPGEN 3392
DI unsigned xb_ld(unsigned* p) { return __hip_atomic_load(p, __ATOMIC_RELAXED, __HIP_MEMORY_SCOPE_AGENT); }
DI unsigned xb_add(unsigned* p, unsigned v) { return __hip_atomic_fetch_add(p, v, __ATOMIC_RELAXED, __HIP_MEMORY_SCOPE_AGENT); }
DI unsigned xb_xcc_id() { return (unsigned)__builtin_amdgcn_s_getreg((3 << 11) | 20) & 0xFu; }
struct GBar {
  unsigned* bar; unsigned x, nloc, nx, gen;
  DI void post() { x = xb_xcc_id(); if (__builtin_amdgcn_workitem_id_x() == 0) (void)xb_add(&bar[XB_XCNT(x)], 1u); }
  DI void census() {
    unsigned mine = 0, cnt = 0;
    for (unsigned j = 0; j < 16; ++j) { const unsigned c = xb_ld(&bar[XB_XCNT(j)]); cnt += c > 0u ? 1u : 0u; mine = j == x ? c : mine; }
    nloc = __builtin_amdgcn_readfirstlane(mine > 0u ? mine : 1u); nx = __builtin_amdgcn_readfirstlane(cnt > 0u ? cnt : 1u); gen = 0;
  }
  DI void sync() {
    asm volatile("s_waitcnt vmcnt(0)" ::: "memory");
    __syncthreads();
    if (__builtin_amdgcn_workitem_id_x() == 0) {
      __builtin_amdgcn_s_waitcnt(0);
      const unsigned old = xb_add(&bar[XB_XSUB(x)], 1u);
      if (old + 1u == (gen + 1u) * nloc) {
        __builtin_amdgcn_fence(__ATOMIC_RELEASE, "agent");
        asm volatile("s_waitcnt vmcnt(0)" ::: "memory");
        const unsigned og = xb_add(&bar[XB_TOP], 1u);
        if (og + 1u == (gen + 1u) * nx) xb_add(&bar[XB_TOPGEN], 1u);
        else { while (xb_ld(&bar[XB_TOPGEN]) == gen) __builtin_amdgcn_s_sleep(1); }
        __builtin_amdgcn_fence(__ATOMIC_ACQUIRE, "agent");
        xb_add(&bar[XB_XGEN(x)], 1u);
        asm volatile("s_waitcnt vmcnt(0)" ::: "memory");
      } else {
        while (xb_ld(&bar[XB_XGEN(x)]) == gen) __builtin_amdgcn_s_sleep(1);
        __builtin_amdgcn_fence(__ATOMIC_ACQUIRE, "agent");
        asm volatile("s_waitcnt vmcnt(0)" ::: "memory");
      }
    }
    gen += 1u;
    __syncthreads();
  }
};

DI void mods_phase(const Params& P, unsigned char* smem) {
  float* s = (float*)smem;
  const int tid = otid();
  {
    float2* TW = (float2*)(P.ws + OFF_TW);
    for (int k = blockIdx.x * NTHR + tid; k < 8192; k += gridDim.x * NTHR) {
      float sn, cs;
      sincospif((float)k * (1.f / 8192.f), &sn, &cs);
      TW[k] = float2{cs, -sn};
    }
  }
  for (int it = blockIdx.x; it < 36; it += gridDim.x) {
    const int l = it / 18, n = (it % 18) * 512 + tid;
    __syncthreads();
    for (int i = tid; i < 5120; i += NTHR) { float c = i < 4096 ? P.in[1][i] : P.in[3][i - 4096]; s[i] = siluf(c); }
    __syncthreads();
    float a0 = 0, a1 = 0, a2 = 0, a3 = 0, a4 = 0;
    const float* w = P.in[4] + (size_t)l * 1024 * 9216 + n;
#pragma unroll 8
    for (int k = 0; k < 1024; ++k) {
      float wv = w[(size_t)k * 9216];
      a0 += s[k] * wv; a1 += s[1024 + k] * wv; a2 += s[2048 + k] * wv; a3 += s[3072 + k] * wv; a4 += s[4096 + k] * wv;
    }
    float bb = P.in[5][l * 9216 + n];
    float* m = (float*)(P.ws + OFF_MODS) + (size_t)l * 5 * 9216 + n;
    m[0] = a0 + bb; m[9216] = a1 + bb; m[2 * 9216] = a2 + bb; m[3 * 9216] = a3 + bb; m[4 * 9216] = a4 + bb;
  }
}

DI void hid3_phase(const Params& P, int l, unsigned char* smem) {
  float* emb = (float*)smem;
  float* hA = emb + 64 * 33;
  float* hB = hA + 64 * 65;
  const int tid = otid(), p = tid & 63, fg = tid >> 6;
  const float* w1 = P.in[15] + l * 33 * 64; const float* b1 = P.in[16] + l * 64;
  const float* w2 = P.in[17] + l * 4096;    const float* b2 = P.in[18] + l * 64;
  const float* w3 = P.in[19] + l * 4096;    const float* b3 = P.in[20] + l * 64;
  const float* fr = P.in[22] + l * 64;
  u16* HID = (u16*)(P.ws + OFF_HID3);
  for (int it = blockIdx.x; it < 132; it += gridDim.x) {
    const int L = it < 128 ? 8192 : 256;
    const int pos0 = it < 128 ? it * 64 : (it - 128) * 64;
    u16* outp = HID + (size_t)(it < 128 ? pos0 : 8192 + pos0) * 64;
    __syncthreads();
    for (int e = tid; e < 64 * 33; e += NTHR) {
      int pp = e / 33, j = e % 33;
      float posf = (float)(pos0 + pp);
      float tl = posf / (float)(L - 1);
      float wang = (6.283185307179586f / (float)L) * posf;
      float v;
      if (j == 0) v = tl;
      else {
        int bi = (j - 1) & 15;
        float band = 1e-4f + (float)bi * ((15.f - 1e-4f) / 15.f);
        float ang = band * wang;
        v = (j <= 16) ? cosf(ang) : -sinf(ang);
      }
      emb[pp * 33 + j] = v;
    }
    __syncthreads();
    for (int ff = 0; ff < 8; ++ff) {
      int f = fg * 8 + ff; float a = b1[f];
      for (int j = 0; j < 33; ++j) a += emb[p * 33 + j] * w1[j * 64 + f];
      hA[p * 65 + f] = sinf(fr[f] * a);
    }
    __syncthreads();
    for (int ff = 0; ff < 8; ++ff) {
      int f = fg * 8 + ff; float a = b2[f];
      for (int j = 0; j < 64; ++j) a += hA[p * 65 + j] * w2[j * 64 + f];
      hB[p * 65 + f] = sinf(fr[f] * a);
    }
    __syncthreads();
    for (int ff = 0; ff < 8; ++ff) {
      int f = fg * 8 + ff; float a = b3[f];
      for (int j = 0; j < 64; ++j) a += hB[p * 65 + j] * w3[j * 64 + f];
      outp[p * 64 + f] = f2bf(sinf(fr[f] * a));
    }
  }
}

DI void conv_tile(const float* __restrict__ src, int K, int N, u16* __restrict__ dst, int tile, bool perm13, unsigned char* smem) {
  float* t = (float*)smem;
  const int tid = otid();
  const int ntn = N >> 6;
  const int k0 = (tile / ntn) * 64, n0 = (tile % ntn) * 64;
  __syncthreads();
  {
    int kk = tid >> 4, nn = (tid & 15) * 4;
    for (int it = 0; it < 2; ++it) {
      float4 v = *(const float4*)(src + (size_t)(k0 + kk + 32 * it) * N + n0 + nn);
      float* d = t + (kk + 32 * it) * 65 + nn;
      d[0] = v.x; d[1] = v.y; d[2] = v.z; d[3] = v.w;
    }
  }
  __syncthreads();
  {
    int nn = tid >> 3, kc = (tid & 7) * 8;
    int n = n0 + nn;
    if (perm13) { n = n < 2816 ? ((n >> 4) * 32 + (n & 15)) : (((n - 2816) >> 4) * 32 + 16 + ((n - 2816) & 15)); }
    uint4 o;
    o.x = pack2(t[(kc + 0) * 65 + nn], t[(kc + 1) * 65 + nn]);
    o.y = pack2(t[(kc + 2) * 65 + nn], t[(kc + 3) * 65 + nn]);
    o.z = pack2(t[(kc + 4) * 65 + nn], t[(kc + 5) * 65 + nn]);
    o.w = pack2(t[(kc + 6) * 65 + nn], t[(kc + 7) * 65 + nn]);
    *(uint4*)(dst + (size_t)n * K + k0 + kc) = o;
  }
}

DI void convert_phase(const Params& P, int l, unsigned char* smem) {
  u16* WB = (u16*)(P.ws + OFF_WB);
  for (int it = blockIdx.x; it < 6848; it += gridDim.x) {
    int i = it;
    if (i < 1408) { conv_tile(P.in[7] + (size_t)l * 1024 * 5632, 1024, 5632, WB + W_13A, i, true, smem); continue; } i -= 1408;
    if (i < 704)  { conv_tile(P.in[8] + (size_t)l * 2816 * 1024, 2816, 1024, WB + W_2A, i, false, smem); continue; } i -= 704;
    if (i < 1904) { conv_tile(P.in[10] + (size_t)l * 1024 * 7616, 1024, 7616, WB + W_IN, i, false, smem); continue; } i -= 1904;
    if (i < 48)   { conv_tile(P.in[25] + (size_t)l * 256 * 768, 256, 768, WB + W_UQ, i, false, smem); continue; } i -= 48;
    if (i < 32)   { conv_tile(P.in[27] + (size_t)l * 128 * 1024, 128, 1024, WB + W_UKV, i, false, smem); continue; } i -= 32;
    if (i < 128)  { conv_tile(P.in[32] + (size_t)l * 512 * 1024, 512, 1024, WB + W_BRA, i, false, smem); continue; } i -= 128;
    if (i < 128)  { conv_tile(P.in[33] + (size_t)l * 512 * 1024, 512, 1024, WB + W_BRB, i, false, smem); continue; } i -= 128;
    if (i < 128)  { conv_tile(P.in[34] + (size_t)l * 512 * 1024, 512, 1024, WB + W_BRC, i, false, smem); continue; } i -= 128;
    if (i < 256)  { conv_tile(P.in[35] + (size_t)l * 1024 * 1024, 1024, 1024, WB + W_OUT, i, false, smem); continue; } i -= 256;
    if (i < 1408) { conv_tile(P.in[37] + (size_t)l * 1024 * 5632, 1024, 5632, WB + W_13B, i, true, smem); continue; } i -= 1408;
    conv_tile(P.in[38] + (size_t)l * 2816 * 1024, 2816, 1024, WB + W_2B, i, false, smem);
  }
}

DI void norm_phase(const Params& P, int l, int which, int nrows, bool first) {
  const int tid_ = otid(), lane = tid_ & 63, w = tid_ >> 6;
  const float* gw = (which == 0 ? P.in[6] : which == 1 ? P.in[9] : P.in[36]) + l * 1024;
  u16* HB = (u16*)(P.ws + OFF_HB);
  for (int row = blockIdx.x * 8 + w; row < nrows; row += gridDim.x * 8) {
    float* xr = xrow(P, row);
    const float* src = first ? (row < RL ? P.in[0] + (size_t)row * 1024 : P.in[2] + (size_t)(row - RL) * 1024) : xr;
    float4 v[4];
    float ss = 0.f;
    for (int j = 0; j < 4; ++j) {
      v[j] = ((const float4*)src)[j * 64 + lane];
      ss += v[j].x * v[j].x + v[j].y * v[j].y + v[j].z * v[j].z + v[j].w * v[j].w;
    }
    ss = wave_sum(ss, lane);
    float rstd = rsqrtf(ss * (1.f / 1024.f) + 1e-6f);
    const float* md = modp(P, l, row) + which * 3 * 1024;
    for (int j = 0; j < 4; ++j) {
      if (first) ((float4*)xr)[j * 64 + lane] = v[j];
      int col = (j * 64 + lane) * 4;
      float4 g = *(const float4*)(gw + col);
      float4 sh = *(const float4*)(md + col);
      float4 sc = *(const float4*)(md + 1024 + col);
      uint2 o;
      o.x = pack2(v[j].x * rstd * g.x * (1.f + sc.x) + sh.x, v[j].y * rstd * g.y * (1.f + sc.y) + sh.y);
      o.y = pack2(v[j].z * rstd * g.z * (1.f + sc.z) + sh.z, v[j].w * rstd * g.w * (1.f + sc.w) + sh.w);
      *(uint2*)(HB + (size_t)row * 1024 + col) = o;
    }
  }
}

#define LDSP(p) ((__attribute__((address_space(3))) unsigned*)(p))
#define GLBP(p) ((__attribute__((address_space(1))) const unsigned*)(p))
#define WAIT_VM(n) asm volatile("s_waitcnt vmcnt(" #n ")" ::: "memory")
#define RAW_BARRIER() do { asm volatile("s_waitcnt lgkmcnt(0)" ::: "memory"); __builtin_amdgcn_s_barrier(); asm volatile("" ::: "memory"); } while (0)

template <bool SWAP = false>
DI void gemm_main(f32x4 (&acc)[4][4], const u16* __restrict__ Act, int lda, const u16* __restrict__ Wt, int ldw, int K,
                  int row0, int col0, unsigned char* smem) {
  const int tid = otid(), lane = tid & 63, w = tid >> 6, wt = w & 3, wc = w >> 2;
  const int lr = tid >> 3, lc = (tid & 7) ^ ((lr >> 1) & 7);
  const u16* srcA = Act + (size_t)(row0 + lr) * lda + lc * 8;
  const u16* srcW = Wt + (size_t)(col0 + lr) * ldw + lc * 8;
  const int nk = K >> 6;
  const int fr = lane & 15, fq = lane >> 4, key = (fr >> 1) & 7;
  unsigned char* wbase = smem + w * 1024;
#define GM_DMA(KT, ST) do { const int k0_ = (KT) * 64; unsigned char* d_ = wbase + (ST) * 49152; \
    __builtin_amdgcn_global_load_lds(GLBP(srcA + k0_), LDSP(d_), 16, 0, 0); \
    __builtin_amdgcn_global_load_lds(GLBP(srcA + (size_t)64 * lda + k0_), LDSP(d_ + 8192), 16, 0, 0); \
    __builtin_amdgcn_global_load_lds(GLBP(srcA + (size_t)128 * lda + k0_), LDSP(d_ + 16384), 16, 0, 0); \
    __builtin_amdgcn_global_load_lds(GLBP(srcA + (size_t)192 * lda + k0_), LDSP(d_ + 24576), 16, 0, 0); \
    __builtin_amdgcn_global_load_lds(GLBP(srcW + k0_), LDSP(d_ + 32768), 16, 0, 0); \
    __builtin_amdgcn_global_load_lds(GLBP(srcW + (size_t)64 * ldw + k0_), LDSP(d_ + 40960), 16, 0, 0); } while (0)
#define GM_FRAGS(A_, B_, ST, KS) do { const unsigned char* base_ = smem + (ST) * 49152; const int po_ = (((KS) * 4 + fq) ^ key) * 16; \
    _Pragma("unroll") for (int ct = 0; ct < 4; ++ct) A_[ct] = *(const bf16x8*)(base_ + (256 + wc * 64 + ct * 16 + fr) * 128 + po_); \
    _Pragma("unroll") for (int tt = 0; tt < 4; ++tt) B_[tt] = *(const bf16x8*)(base_ + (wt * 64 + tt * 16 + fr) * 128 + po_); } while (0)
#define GM_MMA(A_, B_) do { \
    _Pragma("unroll") for (int ct = 0; ct < 4; ++ct) \
      _Pragma("unroll") for (int tt = 0; tt < 4; ++tt) \
        acc[ct][tt] = SWAP ? __builtin_amdgcn_mfma_f32_16x16x32_bf16(B_[tt], A_[ct], acc[ct][tt], 0, 0, 0) \
                           : __builtin_amdgcn_mfma_f32_16x16x32_bf16(A_[ct], B_[tt], acc[ct][tt], 0, 0, 0); } while (0)
  bf16x8 fa0[4], fb0[4], fa1[4], fb1[4];
  WAIT_VM(0);
  RAW_BARRIER();
  GM_DMA(0, 0);
  if (nk > 1) GM_DMA(1, 1);
  if (nk > 2) GM_DMA(2, 2);
  if (nk > 2) WAIT_VM(12); else if (nk > 1) WAIT_VM(6); else WAIT_VM(0);
  RAW_BARRIER();
  GM_FRAGS(fa0, fb0, 0, 0);
  int st = 0;
  for (int kt = 0; kt < nk; ++kt) {
    const int st1 = st == 2 ? 0 : st + 1;
    GM_FRAGS(fa1, fb1, st, 1);
    GM_MMA(fa0, fb0);
    if (kt + 1 < nk) {
      if (kt + 2 < nk) WAIT_VM(6); else WAIT_VM(0);
      RAW_BARRIER();
      if (kt + 3 < nk) GM_DMA(kt + 3, st);
      GM_FRAGS(fa0, fb0, st1, 0);
    }
    GM_MMA(fa1, fb1);
    st = st1;
  }
#undef GM_FRAGS
#undef GM_MMA
#undef GM_DMA
}

DI void zero_acc(f32x4 (&acc)[4][4]) {
#pragma unroll
  for (int a = 0; a < 4; ++a)
#pragma unroll
    for (int b = 0; b < 4; ++b) acc[a][b] = f32x4{0.f, 0.f, 0.f, 0.f};
}

struct TileIter {
  int ntn, nmain_it, ntot_it, x, slot, nslot, rem0;
  DI TileIter(int ntm, int ntn_) {
    ntn = ntn_;
    x = blockIdx.x & 7; slot = blockIdx.x >> 3; nslot = gridDim.x >> 3;
    const int nmain = (ntm >> 3) * ntn;
    rem0 = (ntm >> 3) << 3;
    const int nrem = (ntm - rem0) * ntn;
    nmain_it = slot < nmain ? (nmain - slot + nslot - 1) / nslot : 0;
    const int nrem_it = (int)blockIdx.x < nrem ? (nrem - (int)blockIdx.x + (int)gridDim.x - 1) / (int)gridDim.x : 0;
    ntot_it = nmain_it + nrem_it;
  }
  DI void get(int i, int& rt, int& ct) const {
    if (i < nmain_it) { const int q = slot + i * nslot; rt = (q / ntn) * 8 + x; ct = q % ntn; }
    else { const int j = blockIdx.x + (i - nmain_it) * gridDim.x; rt = rem0 + j / ntn; ct = j % ntn; }
  }
};

template <bool SWAP = false, class Epi>
DI void gemm_phase(const u16* Act, int lda, const u16* Wt, int ldw, int K, int Mrows, int Ncols, unsigned char* smem, Epi epi,
                   int ct_mul = 1, int ct_off = 0) {
  const int ntn = (Ncols + 127) >> 7, ntm = Mrows >> 8;
  const int tid_ = otid(), lane = tid_ & 63, w = tid_ >> 6, wt = w & 3, wc = w >> 2;
  const TileIter ti(ntm, ntn);
  for (int i = 0; i < ti.ntot_it; ++i) {
    int rt_, ct_;
    ti.get(i, rt_, ct_);
    const int row0 = rt_ * 256, col0 = (ct_ * ct_mul + ct_off) * 128;
    f32x4 acc[4][4];
    zero_acc(acc);
    gemm_main<SWAP>(acc, Act, lda, Wt, ldw, K, row0, col0, smem);
    const int rbase = row0 + wt * 64 + (SWAP ? (lane >> 4) * 4 : (lane & 15));
    const int cbase = col0 + wc * 64 + (SWAP ? (lane & 15) : (lane >> 4) * 4);
    epi(acc, rbase, cbase);
  }
}

DI void gemm_main2(f32x4 (&acc)[8][4], const u16* __restrict__ Act, int lda, const u16* __restrict__ Wt, int ldw, int K,
                   int row0, int col0, unsigned char* smem) {
  const int tid = otid(), lane = tid & 63, w = tid >> 6, wt = w & 3, wc = w >> 2;
  const int lr = tid >> 2, lc = (tid & 3) ^ ((lr >> 2) & 3);
  const u16* srcA = Act + (size_t)(row0 + lr) * lda + lc * 8;
  const u16* srcW = Wt + (size_t)(col0 + lr) * ldw + lc * 8;
  const int nk = K >> 5;
  const int fr = lane & 15, fq = lane >> 4;
  const int po = (fq ^ ((fr >> 2) & 3)) * 16;
  unsigned char* wbase = smem + w * 1024;
#define G2_DMA(KT, ST) do { const int k0_ = (KT) * 32; unsigned char* d_ = wbase + (ST) * 32768; \
    __builtin_amdgcn_global_load_lds(GLBP(srcA + k0_), LDSP(d_), 16, 0, 0); \
    __builtin_amdgcn_global_load_lds(GLBP(srcA + (size_t)128 * lda + k0_), LDSP(d_ + 8192), 16, 0, 0); \
    __builtin_amdgcn_global_load_lds(GLBP(srcW + k0_), LDSP(d_ + 16384), 16, 0, 0); \
    __builtin_amdgcn_global_load_lds(GLBP(srcW + (size_t)128 * ldw + k0_), LDSP(d_ + 24576), 16, 0, 0); } while (0)
  WAIT_VM(0);
  RAW_BARRIER();
  G2_DMA(0, 0);
  if (nk > 1) G2_DMA(1, 1);
  int st = 0;
  for (int kt = 0; kt < nk; ++kt) {
    if (kt + 1 < nk) WAIT_VM(4); else WAIT_VM(0);
    RAW_BARRIER();
    if (kt + 2 < nk) { const int s2 = st >= 1 ? st - 1 : 2; G2_DMA(kt + 2, s2); }
    const unsigned char* base = smem + st * 32768;
    __builtin_amdgcn_iglp_opt(1);
    bf16x8 a[8], b[4];
#pragma unroll
    for (int ct = 0; ct < 8; ++ct) a[ct] = *(const bf16x8*)(base + (256 + wc * 128 + ct * 16 + fr) * 64 + po);
#pragma unroll
    for (int tt = 0; tt < 4; ++tt) b[tt] = *(const bf16x8*)(base + (wt * 64 + tt * 16 + fr) * 64 + po);
#pragma unroll
    for (int ct = 0; ct < 8; ++ct)
#pragma unroll
      for (int tt = 0; tt < 4; ++tt) acc[ct][tt] = __builtin_amdgcn_mfma_f32_16x16x32_bf16(a[ct], b[tt], acc[ct][tt], 0, 0, 0);
    st = st == 2 ? 0 : st + 1;
  }
#undef G2_DMA
}

template <class Epi>
DI void gemm_phase2(const u16* Act, int lda, const u16* Wt, int ldw, int K, int Mrows, int Ncols, unsigned char* smem, Epi epi) {
  const int ntn = Ncols >> 8, ntm = Mrows >> 8;
  const int tid_ = otid(), lane = tid_ & 63, w = tid_ >> 6, wt = w & 3, wc = w >> 2;
  const TileIter ti(ntm, ntn);
  for (int i = 0; i < ti.ntot_it; ++i) {
    int rt_, ct_;
    ti.get(i, rt_, ct_);
    const int row0 = rt_ * 256, col0 = ct_ * 256;
    f32x4 acc[8][4];
#pragma unroll
    for (int a = 0; a < 8; ++a)
#pragma unroll
      for (int b = 0; b < 4; ++b) acc[a][b] = f32x4{0.f, 0.f, 0.f, 0.f};
    gemm_main2(acc, Act, lda, Wt, ldw, K, row0, col0, smem);
    epi(acc, row0 + wt * 64 + (lane & 15), col0 + wc * 128 + (lane >> 4) * 4);
  }
}

DI float lb_value(const Params& P, int dir, int l, int k) {
  if (l == 0) return 0.f;
  float a = P.in[11][(dir * 2 + 0) * 512 + k], b = P.in[11][(dir * 2 + 1) * 512 + k];
  float m = fmaxf(a, b);
  float ea = __expf(a - m), eb = __expf(b - m);
  return eb / (ea + eb);
}

DI void hgrn_h1(const Params& P, int l, unsigned char* smem) {
  u16* PA = (u16*)(P.ws + OFF_BIG);
  u16* YA = (u16*)(P.ws + OFF_YA);
  u16* OF = (u16*)(P.ws + OFF_YB);
  u16* OB = (u16*)(P.ws + OFF_YC);
  float* DEC = (float*)(P.ws + OFF_DEC);
  u16* sQF = (u16*)smem;
  u16* sKF = sQF + 64 * 136;
  u16* sQB = sKF + 64 * 136;
  u16* sKB = sQB + 64 * 136;
  u16* sVT = sKB + 64 * 136;
  u16* sAT = sVT + 128 * 72;
  float* ps = (float*)(sAT + 2 * 64 * 72);
  const int tid = otid(), lane = tid & 63, w = tid >> 6;
  const int d = tid & 127, sq = tid >> 7;
  for (int it = blockIdx.x; it < 528 * 4; it += gridDim.x) {
    const int ch = it >> 2, h = it & 3;
    const int row0 = ch * 64;
    const float lbf = lb_value(P, 0, l, h * 128 + d), lbb = lb_value(P, 1, l, h * 128 + d);
    float gf[16], gb[16], kf[16], kb[16], qs[16];
    u16 vv[16];
    float pf = 0.f, pb = 0.f;
    {
      const u16* src = PA + (size_t)(row0 + sq * 16) * 2560 + h * 128 + d;
#pragma unroll
      for (int j = 0; j < 16; ++j) {
        float q = bf2f(src[(size_t)j * 2560]);
        float zf = bf2f(src[(size_t)j * 2560 + 512]);
        float zb = bf2f(src[(size_t)j * 2560 + 1024]);
        vv[j] = src[(size_t)j * 2560 + 1536];
        qs[j] = siluf(q) * 0.08838834764831845f;
        float sf = sigmf(zf), sb = sigmf(zb);
        float ff = lbf + (1.f - lbf) * sf, fb = lbb + (1.f - lbb) * sb;
        gf[j] = __logf(ff); gb[j] = __logf(fb);
        kf[j] = (1.f - lbf) * (1.f - sf); kb[j] = (1.f - lbb) * (1.f - sb);
        pf += gf[j]; pb += gb[j];
      }
    }
    asm volatile("s_waitcnt vmcnt(0)" ::: "memory");
    __syncthreads();
    ps[(0 * 4 + sq) * 128 + d] = pf;
    ps[(1 * 4 + sq) * 128 + d] = pb;
    __syncthreads();
    float offf = 0.f, totf = 0.f, offb = 0.f, totb = 0.f;
#pragma unroll
    for (int s2 = 0; s2 < 4; ++s2) {
      float a = ps[s2 * 128 + d], b = ps[(4 + s2) * 128 + d];
      totf += a; totb += b;
      if (s2 < sq) offf += a;
      if (s2 > sq) offb += b;
    }
    if (sq == 0) {
      DEC[((size_t)(0 * 528 + ch) * 4 + h) * 128 + d] = __expf(totf);
      DEC[((size_t)(1 * 528 + ch) * 4 + h) * 128 + d] = __expf(totb);
    }
    {
      unsigned kh[8];
      float bc = offf;
#pragma unroll
      for (int j = 0; j < 16; ++j) {
        bc += gf[j];
        const int s = sq * 16 + j;
        u16 qt = f2bf(qs[j] * __expf(bc));
        sQF[s * 136 + d] = qt;
        sKF[s * 136 + d] = f2bf(kf[j] * __expf(fminf(-bc, 80.f)));
        PA[(size_t)(row0 + s) * 2560 + h * 128 + d] = qt;
        u16 khv = f2bf(kf[j] * __expf(totf - bc));
        if (j & 1) kh[j >> 1] |= ((unsigned)khv) << 16; else kh[j >> 1] = khv;
      }
      u16* dst = PA + (size_t)(row0 + (d >> 1)) * 2560 + 512 + h * 128 + (d & 1) * 64 + sq * 16;
      *(uint4*)dst = uint4{kh[0], kh[1], kh[2], kh[3]};
      *(uint4*)(dst + 8) = uint4{kh[4], kh[5], kh[6], kh[7]};
    }
    {
      unsigned kh[8];
      float bc = offb;
#pragma unroll
      for (int j = 15; j >= 0; --j) {
        bc += gb[j];
        const int s = sq * 16 + j;
        u16 qt = f2bf(qs[j] * __expf(bc));
        sQB[s * 136 + d] = qt;
        sKB[s * 136 + d] = f2bf(kb[j] * __expf(fminf(-bc, 80.f)));
        YA[(size_t)(row0 + s) * 512 + h * 128 + d] = qt;
        u16 khv = f2bf(kb[j] * __expf(totb - bc));
        if (j & 1) kh[j >> 1] = ((unsigned)khv) << 16; else kh[j >> 1] |= khv;
      }
      u16* dst = PA + (size_t)(row0 + (d >> 1)) * 2560 + 1024 + h * 128 + (d & 1) * 64 + sq * 16;
      *(uint4*)dst = uint4{kh[0], kh[1], kh[2], kh[3]};
      *(uint4*)(dst + 8) = uint4{kh[4], kh[5], kh[6], kh[7]};
    }
    {
      unsigned vp[8];
#pragma unroll
      for (int j = 0; j < 8; ++j) vp[j] = (unsigned)vv[2 * j] | ((unsigned)vv[2 * j + 1] << 16);
      u16* dst = PA + (size_t)(row0 + (d >> 1)) * 2560 + 1536 + h * 128 + (d & 1) * 64 + sq * 16;
      *(uint4*)dst = uint4{vp[0], vp[1], vp[2], vp[3]};
      *(uint4*)(dst + 8) = uint4{vp[4], vp[5], vp[6], vp[7]};
      u16* ld = sVT + d * 72 + sq * 16;
      *(uint4*)ld = uint4{vp[0], vp[1], vp[2], vp[3]};
      *(uint4*)(ld + 8) = uint4{vp[4], vp[5], vp[6], vp[7]};
    }
    __syncthreads();
    {
      const int dir = w >> 2, tt = w & 3;
      const u16* sQ = dir ? sQB : sQF;
      const u16* sK = dir ? sKB : sKF;
      const int fr = lane & 15, fq = lane >> 4;
      bf16x8 a[4];
#pragma unroll
      for (int ks = 0; ks < 4; ++ks) a[ks] = *(const bf16x8*)(sQ + (tt * 16 + fr) * 136 + ks * 32 + fq * 8);
#pragma unroll
      for (int st = 0; st < 4; ++st) {
        f32x4 c = {0.f, 0.f, 0.f, 0.f};
#pragma unroll
        for (int ks = 0; ks < 4; ++ks) {
          bf16x8 b = *(const bf16x8*)(sK + (st * 16 + fr) * 136 + ks * 32 + fq * 8);
          c = __builtin_amdgcn_mfma_f32_16x16x32_bf16(a[ks], b, c, 0, 0, 0);
        }
        const int s = st * 16 + fr;
#pragma unroll
        for (int i = 0; i < 4; ++i) {
          const int t = tt * 16 + fq * 4 + i;
          bool keep = dir ? (s >= t) : (s <= t);
          sAT[(dir * 64 + t) * 72 + s] = keep ? f2bf(c[i]) : (u16)0;
        }
      }
    }
    __syncthreads();
    {
      const int dir = w >> 2;
      const int fr = lane & 15, fq = lane >> 4;
      u16* OX = dir ? OB : OF;
#pragma unroll
      for (int mi = 0; mi < 2; ++mi) {
        const int mt = (w & 3) * 2 + mi;
        bf16x8 a0 = *(const bf16x8*)(sVT + (mt * 16 + fr) * 72 + fq * 8);
        bf16x8 a1 = *(const bf16x8*)(sVT + (mt * 16 + fr) * 72 + 32 + fq * 8);
#pragma unroll
        for (int nt = 0; nt < 4; ++nt) {
          bf16x8 b0 = *(const bf16x8*)(sAT + (dir * 64 + nt * 16 + fr) * 72 + fq * 8);
          bf16x8 b1 = *(const bf16x8*)(sAT + (dir * 64 + nt * 16 + fr) * 72 + 32 + fq * 8);
          f32x4 c = {0.f, 0.f, 0.f, 0.f};
          c = __builtin_amdgcn_mfma_f32_16x16x32_bf16(a0, b0, c, 0, 0, 0);
          c = __builtin_amdgcn_mfma_f32_16x16x32_bf16(a1, b1, c, 0, 0, 0);
          const int t = nt * 16 + fr, dv = mt * 16 + fq * 4;
          *(uint2*)(OX + (size_t)(row0 + t) * 512 + h * 128 + dv) = uint2{pack2(c[0], c[1]), pack2(c[2], c[3])};
        }
      }
    }
  }
}

struct H2Regs { uint4 qf[4]; uint2 oold; uint4 kt[2]; uint4 vt[2]; float4 dec; };

DI void hgrn_h2(const Params& P, unsigned char* smem) {
  const u16* PA = (const u16*)(P.ws + OFF_BIG);
  const u16* YA = (const u16*)(P.ws + OFF_YA);
  const float* DEC = (const float*)(P.ws + OFF_DEC);
  u16* sS = (u16*)smem;
  const int tid = otid(), lane = tid & 63, w = tid >> 6, fr = lane & 15, fq = lane >> 4;
  for (int it = blockIdx.x; it < 256; it += gridDim.x) {
    const int ds = it & 7, dir = (it >> 3) & 1, h = (it >> 4) & 3, b = it >> 6;
    u16* OX = (u16*)(P.ws + (dir ? OFF_YC : OFF_YB));
    __syncthreads();
    for (int i = tid; i < 16 * 136; i += NTHR) sS[i] = 0;
    f32x4 S = {0.f, 0.f, 0.f, 0.f};
    auto chunk_of = [&](int step) -> int {
      if (step < 4) return 512 + b * 4 + (dir ? 3 - step : step);
      int c = step - 4;
      return b * 128 + (dir ? 127 - c : c);
    };
    auto load = [&](int step, H2Regs& r) {
      const int ch = chunk_of(step), row0 = ch * 64;
      if (w < 4) {
        const int t = w * 16 + fr;
        const u16* qsrc = dir ? (YA + (size_t)(row0 + t) * 512 + h * 128) : (PA + (size_t)(row0 + t) * 2560 + h * 128);
#pragma unroll
        for (int ks = 0; ks < 4; ++ks) r.qf[ks] = *(const uint4*)(qsrc + ks * 32 + fq * 8);
        r.oold = *(const uint2*)(OX + (size_t)(row0 + t) * 512 + h * 128 + ds * 16 + fq * 4);
      }
      const int dd = w * 16 + fr;
      const u16* ksrc = PA + (size_t)(row0 + (dd >> 1)) * 2560 + (dir ? 1024 : 512) + h * 128 + (dd & 1) * 64;
      const int dv = ds * 16 + fr;
      const u16* vsrc = PA + (size_t)(row0 + (dv >> 1)) * 2560 + 1536 + h * 128 + (dv & 1) * 64;
#pragma unroll
      for (int ks = 0; ks < 2; ++ks) {
        r.kt[ks] = *(const uint4*)(ksrc + ks * 32 + fq * 8);
        r.vt[ks] = *(const uint4*)(vsrc + ks * 32 + fq * 8);
      }
      r.dec = *(const float4*)(DEC + ((size_t)(dir * 528 + ch) * 4 + h) * 128 + w * 16 + fq * 4);
    };
    H2Regs cur, nxt;
    load(0, cur);
    __syncthreads();
    for (int step = 0; step < 132; ++step) {
      if (step + 1 < 132) load(step + 1, nxt);
      const int row0 = chunk_of(step) * 64;
      if (w < 4) {
        f32x4 c = {0.f, 0.f, 0.f, 0.f};
#pragma unroll
        for (int ks = 0; ks < 4; ++ks) {
          bf16x8 a = *(const bf16x8*)(sS + fr * 136 + ks * 32 + fq * 8);
          c = __builtin_amdgcn_mfma_f32_16x16x32_bf16(a, __builtin_bit_cast(bf16x8, cur.qf[ks]), c, 0, 0, 0);
        }
        const int t = w * 16 + fr;
        uint2 o;
        o.x = pack2(blo(cur.oold.x) + c[0], bhi(cur.oold.x) + c[1]);
        o.y = pack2(blo(cur.oold.y) + c[2], bhi(cur.oold.y) + c[3]);
        *(uint2*)(OX + (size_t)(row0 + t) * 512 + h * 128 + ds * 16 + fq * 4) = o;
      }
      S[0] *= cur.dec.x; S[1] *= cur.dec.y; S[2] *= cur.dec.z; S[3] *= cur.dec.w;
#pragma unroll
      for (int ks = 0; ks < 2; ++ks)
        S = __builtin_amdgcn_mfma_f32_16x16x32_bf16(__builtin_bit_cast(bf16x8, cur.kt[ks]), __builtin_bit_cast(bf16x8, cur.vt[ks]), S, 0, 0, 0);
      __syncthreads();
      *(uint2*)(sS + fr * 136 + w * 16 + fq * 4) = uint2{pack2(S[0], S[1]), pack2(S[2], S[3])};
      __syncthreads();
      cur = nxt;
    }
  }
}

DI void hgrn_h3(const Params& P, int l, int nrows) {
  const u16* PA = (const u16*)(P.ws + OFF_BIG);
  const u16* OF = (const u16*)(P.ws + OFF_YB);
  const u16* OB = (const u16*)(P.ws + OFF_YC);
  u16* YA = (u16*)(P.ws + OFF_YA);
  const int tid_ = otid(), lane = tid_ & 63, w = tid_ >> 6;
  const float* gain = P.in[12] + l * 128;
  for (int row = blockIdx.x * 8 + w; row < nrows; row += gridDim.x * 8) {
    uint4 a = *(const uint4*)(OF + (size_t)row * 512 + lane * 8);
    uint4 b = *(const uint4*)(OB + (size_t)row * 512 + lane * 8);
    uint4 g = *(const uint4*)(PA + (size_t)row * 2560 + 2048 + lane * 8);
    float o[8] = {blo(a.x) + blo(b.x), bhi(a.x) + bhi(b.x), blo(a.y) + blo(b.y), bhi(a.y) + bhi(b.y),
                  blo(a.z) + blo(b.z), bhi(a.z) + bhi(b.z), blo(a.w) + blo(b.w), bhi(a.w) + bhi(b.w)};
    float gg[8] = {blo(g.x), bhi(g.x), blo(g.y), bhi(g.y), blo(g.z), bhi(g.z), blo(g.w), bhi(g.w)};
    float ss = 0.f;
    for (int j = 0; j < 8; ++j) ss += o[j] * o[j];
    ss = row16_sum(ss);
    float rstd = rsqrtf(ss * (1.f / 128.f) + 1e-6f);
    const int dv0 = (lane & 15) * 8;
    float y[8];
    for (int j = 0; j < 8; ++j) y[j] = o[j] * rstd * gain[dv0 + j] * siluf(gg[j]);
    *(uint4*)(YA + (size_t)row * 512 + lane * 8) = uint4{pack2(y[0], y[1]), pack2(y[2], y[3]), pack2(y[4], y[5]), pack2(y[6], y[7])};
  }
}

DI float2 cmul(float2 a, float2 b) { return float2{a.x * b.x - a.y * b.y, a.x * b.y + a.y * b.x}; }

DI float2 twd(const float2* TQ, int k) {
  const bool lowq = k <= 2048;
  const float2 e = TQ[lowq ? k : 4096 - k];
  return lowq ? float2{e.x, -e.y} : float2{e.y, -e.x};
}

DI int ph(int i) { return i + (i >> 7); }

DI void bfly_fwd(float2& a0, float2& a1, float2& a2, float2& a3, float2 w1) {
  float2 w2 = cmul(w1, w1);
  float2 b0 = {a0.x + a2.x, a0.y + a2.y};
  float2 b2 = cmul(float2{a0.x - a2.x, a0.y - a2.y}, w1);
  float2 b1 = {a1.x + a3.x, a1.y + a3.y};
  float2 d3 = {a1.x - a3.x, a1.y - a3.y};
  float2 b3 = cmul(float2{d3.y, -d3.x}, w1);
  a0 = float2{b0.x + b1.x, b0.y + b1.y};
  a1 = cmul(float2{b0.x - b1.x, b0.y - b1.y}, w2);
  a2 = float2{b2.x + b3.x, b2.y + b3.y};
  a3 = cmul(float2{b2.x - b3.x, b2.y - b3.y}, w2);
}
DI void bfly_inv(float2& a0, float2& a1, float2& a2, float2& a3, float2 w1) {
  float2 w2 = cmul(w1, w1);
  float2 t = cmul(a1, w2);
  float2 b0 = {a0.x + t.x, a0.y + t.y}, b1 = {a0.x - t.x, a0.y - t.y};
  t = cmul(a3, w2);
  float2 b2 = {a2.x + t.x, a2.y + t.y}, b3 = {a2.x - t.x, a2.y - t.y};
  t = cmul(b2, w1);
  a0 = float2{b0.x + t.x, b0.y + t.y};
  a2 = float2{b0.x - t.x, b0.y - t.y};
  float2 u = cmul(b3, w1);
  t = float2{-u.y, u.x};
  a1 = float2{b1.x + t.x, b1.y + t.y};
  a3 = float2{b1.x - t.x, b1.y - t.y};
}

template <bool INV, int LH>
DI void fft_pass(float2* X, const float2* __restrict__ TW, int tid) {
  constexpr int h = 1 << LH, hh = h >> 1;
  asm volatile("" : "+v"(tid));
  int p0[8], lo[8];
  float2 a0[8], a1[8], a2[8], a3[8], w1[8];
#pragma unroll
  for (int k = 0; k < 8; ++k) {
    const int q = tid + k * NTHR;
    if (LH >= 7) {
      lo[k] = q & (hh - 1);
      const int hi = q >> (LH - 1);
      p0[k] = (hi << (LH + 1)) + lo[k];
    } else {
      const int r = q & 127, bidx = q >> 7;
      lo[k] = bidx & (hh - 1);
      const int hi = bidx >> (LH - 1);
      p0[k] = r * 129 + (hi << (LH + 1)) + lo[k];
    }
    w1[k] = twd(TW, lo[k] << (13 - LH));
  }
#pragma unroll
  for (int k = 0; k < 8; ++k) {
    if (LH >= 7) {
      const int i0 = p0[k];
      a0[k] = X[ph(i0)]; a1[k] = X[ph(i0 + hh)]; a2[k] = X[ph(i0 + h)]; a3[k] = X[ph(i0 + h + hh)];
    } else {
      a0[k] = X[p0[k]]; a1[k] = X[p0[k] + hh]; a2[k] = X[p0[k] + h]; a3[k] = X[p0[k] + h + hh];
    }
  }
#pragma unroll
  for (int k = 0; k < 8; ++k) {
    float2 w = w1[k];
    if (INV) { w.y = -w.y; bfly_inv(a0[k], a1[k], a2[k], a3[k], w); }
    else bfly_fwd(a0[k], a1[k], a2[k], a3[k], w);
    if (LH >= 7) {
      const int i0 = p0[k];
      X[ph(i0)] = a0[k]; X[ph(i0 + hh)] = a1[k]; X[ph(i0 + h)] = a2[k]; X[ph(i0 + h + hh)] = a3[k];
    } else {
      X[p0[k]] = a0[k]; X[p0[k] + hh] = a1[k]; X[p0[k] + h] = a2[k]; X[p0[k] + h + hh] = a3[k];
    }
  }
  __syncthreads();
}

DI void fft_fwd(float2* X, const float2* __restrict__ TW) {
  const int tid = otid();
  fft_pass<false, 13>(X, TW, tid); fft_pass<false, 11>(X, TW, tid); fft_pass<false, 9>(X, TW, tid); fft_pass<false, 7>(X, TW, tid);
  fft_pass<false, 5>(X, TW, tid); fft_pass<false, 3>(X, TW, tid); fft_pass<false, 1>(X, TW, tid);
}
DI void fft_inv(float2* X, const float2* __restrict__ TW) {
  const int tid = otid();
  fft_pass<true, 1>(X, TW, tid); fft_pass<true, 3>(X, TW, tid); fft_pass<true, 5>(X, TW, tid); fft_pass<true, 7>(X, TW, tid);
  fft_pass<true, 9>(X, TW, tid); fft_pass<true, 11>(X, TW, tid); fft_pass<true, 13>(X, TW, tid);
}

DI float hy_delta(int c) {
  const float mn = -3.0701134573253945f, mx = -15.350567286626973f;
  return fabsf(mn + (mx - mn) * ((float)c / 511.f));
}

DI float conv3_at(const u16* seq, int t, int L, float w0, float w1, float w2, float bias) {
  float c = bf2f(seq[t]);
  float a = t > 0 ? bf2f(seq[t - 1]) : 0.f;
  float b = t < L - 1 ? bf2f(seq[t + 1]) : 0.f;
  return a * w0 + c * w1 + b * w2 + bias;
}

DI void hyena_phase(const Params& P, int l, unsigned char* smem) {
  float2* X = (float2*)smem;
  float* ex = (float*)(smem + 132096);
  const u16* PB = (const u16*)(P.ws + OFF_BIG);
  u16* YB = (u16*)(P.ws + OFF_YB);
  const u16* HID = (const u16*)(P.ws + OFF_HID3);
  const float2* TWG = (const float2*)(P.ws + OFF_TW);
  float2* TWL = (float2*)(smem + 134144);
  const float2* TW = TWL;
  float2* FS = (float2*)(P.ws + OFF_BIG + BIG_FSCR) + (size_t)blockIdx.x * 40960;
  const float* w4 = P.in[21] + (size_t)l * 64 * 2048;
  const float* cw = P.in[13] + l * 3 * 1536;
  const float* cb = P.in[14] + l * 1536;
  const int tid = otid();
  __syncthreads();
  for (int k = tid; k <= 2048; k += NTHR) { float2 e = TWG[k]; TWL[k] = float2{e.x, -e.y}; }
  __syncthreads();
  for (int it = blockIdx.x; it < 512; it += gridDim.x) {
    const int xcd = it & 7, j = (it >> 3) & 31, grp = (it >> 8) * 8 + xcd;
    const int c = grp * 32 + j;
    __syncthreads();
    if (tid < 256) { int f = tid & 63, wh = tid >> 6; ex[tid] = w4[f * 2048 + (wh >> 1) * 1024 + (wh & 1) * 512 + c]; }
    __syncthreads();
    const float delta = hy_delta(c);
    float n0 = 0.f, n1 = 0.f;
    {
      const int lane = tid & 63, wv = tid >> 6, fr = lane & 15, fq = lane >> 4;
      bf16x8 wa0, wa1;
      {
        unsigned t0[4], t1[4];
#pragma unroll
        for (int j = 0; j < 4; ++j) {
          const float a0 = fr < 4 ? ex[fr * 64 + fq * 8 + 2 * j] : 0.f, a1 = fr < 4 ? ex[fr * 64 + fq * 8 + 2 * j + 1] : 0.f;
          const float c0 = fr < 4 ? ex[fr * 64 + 32 + fq * 8 + 2 * j] : 0.f, c1 = fr < 4 ? ex[fr * 64 + 32 + fq * 8 + 2 * j + 1] : 0.f;
          t0[j] = pack2(a0, a1); t1[j] = pack2(c0, c1);
        }
        wa0 = __builtin_bit_cast(bf16x8, uint4{t0[0], t0[1], t0[2], t0[3]});
        wa1 = __builtin_bit_cast(bf16x8, uint4{t1[0], t1[1], t1[2], t1[3]});
      }
#pragma unroll 4
      for (int g = wv; g < 1024; g += 8) {
        const int n = g * 16 + fr;
        const int dir = n > 8192 ? 1 : 0;
        const int pos = dir ? 16384 - n : n;
        const uint4* hp = (const uint4*)(HID + (size_t)pos * 64 + fq * 8);
        const bf16x8 b0 = __builtin_bit_cast(bf16x8, hp[0]);
        const bf16x8 b1 = __builtin_bit_cast(bf16x8, hp[4]);
        f32x4 d = {0.f, 0.f, 0.f, 0.f};
        d = __builtin_amdgcn_mfma_f32_16x16x32_bf16(wa0, b0, d, 0, 0, 0);
        d = __builtin_amdgcn_mfma_f32_16x16x32_bf16(wa1, b1, d, 0, 0, 0);
        if (fq == 0) {
          float k0 = dir ? d[2] : d[0], k1 = dir ? d[3] : d[1];
          const float win = __expf(-((float)pos / 8191.f) * delta) + 0.05f;
          k0 *= win; k1 *= win;
          if (n == 8192) { k0 = 0.f; k1 = 0.f; }
          n0 += fabsf(k0); n1 += fabsf(k1);
          X[ph(n)] = float2{k0, k1};
        }
      }
    }
    const float norm0 = block_sum(n0, ex + 256), norm1 = block_sum(n1, ex + 272);
    __syncthreads();
    fft_fwd(X, TW);
    {
      const float s0 = 1.f / (norm0 * 16384.f), s1 = 1.f / (norm1 * 16384.f);
#pragma unroll 4
      for (int p = tid; p < 16384; p += NTHR) {
        const int f = (int)(__brev((unsigned)p) >> 18);
        const int p2 = (int)(__brev((unsigned)((16384 - f) & 16383)) >> 18);
        float2 a = X[ph(p)], b = X[ph(p2)];
        FS[p] = float2{(a.x + b.x) * 0.5f * s0, (a.y - b.y) * 0.5f * s0};
        FS[16384 + p] = float2{(a.y + b.y) * 0.5f * s1, -(a.x - b.x) * 0.5f * s1};
      }
    }
    const float cwz0 = cw[1024 + c], cwz1 = cw[1536 + 1024 + c], cwz2 = cw[3072 + 1024 + c], cbz = cb[1024 + c];
    float2* VS = FS + 32768;
    for (int bp = 0; bp < 2; ++bp) {
      const int rb0 = (2 * bp) * 8192, rb1 = rb0 + 8192;
      const u16* z0 = PB + ((size_t)((2 * bp) * 1536 + 1024 + c) << 13);
      const u16* z1 = PB + ((size_t)((2 * bp + 1) * 1536 + 1024 + c) << 13);
#pragma unroll 1
      for (int o = 0; o < 2; ++o) {
        int tl = tid; asm volatile("" : "+v"(tl));
        __syncthreads();
#pragma unroll
        for (int kb = 0; kb < 8; kb += 4) {
          asm volatile("" : "+v"(tl));
          float2 a0[4], a1[4], w1[4];
#pragma unroll
          for (int k = 0; k < 4; ++k) {
            const int q = tl + (kb + k) * NTHR;
            if (o == 0) {
              a0[k].x = conv3_at(z0, q, 8192, cwz0, cwz1, cwz2, cbz);
              a0[k].y = conv3_at(z1, q, 8192, cwz0, cwz1, cwz2, cbz);
              a1[k].x = conv3_at(z0, q + 4096, 8192, cwz0, cwz1, cwz2, cbz);
              a1[k].y = conv3_at(z1, q + 4096, 8192, cwz0, cwz1, cwz2, cbz);
              VS[q] = a0[k]; VS[q + 4096] = a1[k];
            } else { a0[k] = VS[q]; a1[k] = VS[q + 4096]; }
            w1[k] = twd(TW, q);
          }
#pragma unroll
          for (int k = 0; k < 4; ++k) {
            const int q = tl + (kb + k) * NTHR;
            float2 a2 = {0.f, 0.f}, a3 = {0.f, 0.f};
            bfly_fwd(a0[k], a1[k], a2, a3, w1[k]);
            X[ph(q)] = a0[k]; X[ph(q + 4096)] = a1[k]; X[ph(q + 8192)] = a2; X[ph(q + 12288)] = a3;
          }
        }
        __syncthreads();
        fft_pass<false, 11>(X, TW, tl); fft_pass<false, 9>(X, TW, tl); fft_pass<false, 7>(X, TW, tl);
        fft_pass<false, 5>(X, TW, tl); fft_pass<false, 3>(X, TW, tl);
        {
          const float2* Ks = FS + o * 16384;
#pragma unroll
          for (int kb = 0; kb < 8; kb += 4) {
            asm volatile("" : "+v"(tl));
            float2 e0[4], e1[4], e2[4], e3[4];
            float4 kA[4], kB[4];
#pragma unroll
            for (int k = 0; k < 4; ++k) {
              const int q = tl + (kb + k) * NTHR;
              const int r = q & 127, bidx = q >> 7;
              const int p0 = r * 129 + bidx * 4;
              e0[k] = X[p0]; e1[k] = X[p0 + 1]; e2[k] = X[p0 + 2]; e3[k] = X[p0 + 3];
              const float4* kp = (const float4*)(Ks + r * 128 + bidx * 4);
              kA[k] = kp[0]; kB[k] = kp[1];
            }
#pragma unroll
            for (int k = 0; k < 4; ++k) {
              const int q = tl + (kb + k) * NTHR;
              const int r = q & 127, bidx = q >> 7;
              const int p0 = r * 129 + bidx * 4;
              const float2 one = {1.f, 0.f};
              bfly_fwd(e0[k], e1[k], e2[k], e3[k], one);
              e0[k] = cmul(e0[k], float2{kA[k].x, kA[k].y}); e1[k] = cmul(e1[k], float2{kA[k].z, kA[k].w});
              e2[k] = cmul(e2[k], float2{kB[k].x, kB[k].y}); e3[k] = cmul(e3[k], float2{kB[k].z, kB[k].w});
              bfly_inv(e0[k], e1[k], e2[k], e3[k], one);
              X[p0] = e0[k]; X[p0 + 1] = e1[k]; X[p0 + 2] = e2[k]; X[p0 + 3] = e3[k];
            }
          }
          __syncthreads();
        }
        fft_pass<true, 3>(X, TW, tl); fft_pass<true, 5>(X, TW, tl); fft_pass<true, 7>(X, TW, tl);
        fft_pass<true, 9>(X, TW, tl); fft_pass<true, 11>(X, TW, tl);
        const int gc = o * 512 + c;
        const float g0 = cw[gc], g1 = cw[1536 + gc], g2 = cw[3072 + gc], gbias = cb[gc];
        const float skip = P.in[23][(l * 2 + o) * 512 + c];
        const u16* x0p = PB + ((size_t)((2 * bp) * 1536 + gc) << 13);
        const u16* x1p = PB + ((size_t)((2 * bp + 1) * 1536 + gc) << 13);
#pragma unroll
        for (int kb = 0; kb < 8; kb += 4) {
          asm volatile("" : "+v"(tl));
          float2 a0[4], a1[4], a2[4], a3[4], w1[4], vo0[4], vo1[4];
          float xa[4], xb[4], xc2[4], xd[4];
#pragma unroll
          for (int k = 0; k < 4; ++k) {
            const int q = tl + (kb + k) * NTHR;
            a0[k] = X[ph(q)]; a1[k] = X[ph(q + 4096)]; a2[k] = X[ph(q + 8192)]; a3[k] = X[ph(q + 12288)];
            w1[k] = twd(TW, q); w1[k].y = -w1[k].y;
            vo0[k] = VS[q]; vo1[k] = VS[q + 4096];
            xa[k] = conv3_at(x0p, q, 8192, g0, g1, g2, gbias);
            xb[k] = conv3_at(x1p, q, 8192, g0, g1, g2, gbias);
            xc2[k] = conv3_at(x0p, q + 4096, 8192, g0, g1, g2, gbias);
            xd[k] = conv3_at(x1p, q + 4096, 8192, g0, g1, g2, gbias);
          }
#pragma unroll
          for (int k = 0; k < 4; ++k) {
            const int q = tl + (kb + k) * NTHR;
            bfly_inv(a0[k], a1[k], a2[k], a3[k], w1[k]);
            float2 n0v, n1v;
            n0v.x = xa[k] * (a0[k].x + vo0[k].x * skip);
            n0v.y = xb[k] * (a0[k].y + vo0[k].y * skip);
            n1v.x = xc2[k] * (a1[k].x + vo1[k].x * skip);
            n1v.y = xd[k] * (a1[k].y + vo1[k].y * skip);
            if (o == 0) { VS[q] = n0v; VS[q + 4096] = n1v; }
            else {
              YB[(size_t)(rb0 + q) * 512 + c] = f2bf(n0v.x);
              YB[(size_t)(rb1 + q) * 512 + c] = f2bf(n0v.y);
              YB[(size_t)(rb0 + q + 4096) * 512 + c] = f2bf(n1v.x);
              YB[(size_t)(rb1 + q + 4096) * 512 + c] = f2bf(n1v.y);
            }
          }
        }
      }
    }
  }
}

DI void hyena_ctx_phase(const Params& P, int l, unsigned char* smem) {
  float* kf = (float*)smem;
  float* vz = kf + 1024;
  float* red = vz + 1024;
  const u16* PBC = (const u16*)(P.ws + OFF_BIG) + (size_t)4 * 1536 * 8192;
  u16* YB = (u16*)(P.ws + OFF_YB);
  const u16* HID = (const u16*)(P.ws + OFF_HID3) + (size_t)8192 * 64;
  const float* w4 = P.in[21] + (size_t)l * 64 * 2048;
  const float* cw = P.in[13] + l * 3 * 1536;
  const float* cb = P.in[14] + l * 1536;
  const int tid = otid();
  for (int c = blockIdx.x; c < 512; c += gridDim.x) {
    const float delta = hy_delta(c);
    __syncthreads();
    float n0 = 0.f, n1 = 0.f;
    for (int idx = tid; idx < 1024; idx += NTHR) {
      const int pos = idx & 255, wh = idx >> 8, dir = wh >> 1, o = wh & 1;
      float a = 0.f;
      for (int f = 0; f < 64; ++f) a += bf2f(HID[pos * 64 + f]) * w4[f * 2048 + dir * 1024 + o * 512 + c];
      a *= __expf(-((float)pos / 255.f) * delta) + 0.05f;
      kf[idx] = a;
      if (!(dir == 1 && pos == 0)) { if (o == 0) n0 += fabsf(a); else n1 += fabsf(a); }
    }
    const float norm0 = block_sum(n0, red), norm1 = block_sum(n1, red + 16);
    float vreg[2];
    for (int r = 0; r < 2; ++r) {
      const int idx = tid + r * 512, b = idx >> 8, t = idx & 255;
      vreg[r] = conv3_at(PBC + ((size_t)(b * 1536 + 1024 + c) << 8), t, 256, cw[1024 + c], cw[1536 + 1024 + c], cw[3072 + 1024 + c], cb[1024 + c]);
    }
    for (int o = 0; o < 2; ++o) {
      __syncthreads();
      for (int r = 0; r < 2; ++r) vz[tid + r * 512] = vreg[r];
      __syncthreads();
      const float inv = 1.f / (o == 0 ? norm0 : norm1);
      const int gc = o * 512 + c;
      const float skip = P.in[23][(l * 2 + o) * 512 + c];
      for (int r = 0; r < 2; ++r) {
        const int idx = tid + r * 512, b = idx >> 8, t = idx & 255;
        float y = 0.f;
        for (int s = 0; s < 256; ++s) {
          const int lag = t - s;
          float kk = lag >= 0 ? kf[(0 * 2 + o) * 256 + lag] : kf[(1 * 2 + o) * 256 - lag];
          y += kk * vz[b * 256 + s];
        }
        y *= inv;
        float xg = conv3_at(PBC + ((size_t)(b * 1536 + gc) << 8), t, 256, cw[gc], cw[1536 + gc], cw[3072 + gc], cb[gc]);
        vreg[r] = xg * (y + vreg[r] * skip);
      }
    }
    for (int r = 0; r < 2; ++r) {
      const int idx = tid + r * 512, b = idx >> 8, t = idx & 255;
      YB[(size_t)(RL + b * 256 + t) * 512 + c] = f2bf(vreg[r]);
    }
  }
}

DI float rope_inv(int i) { return exp2f(-(float)(2 * i) * (13.287712379549449f / 32.f)); }

DI float axial_rope_lane(float x, int lane, int t) {
  const int sec = lane >> 5, jj = lane & 31, i = jj & 15;
  const float posc = sec ? (float)(t & 63) : (float)(t >> 6);
  float sn, cs;
  sincosf(posc * rope_inv(i), &sn, &cs);
  float partner = shx(x, 16, lane);
  return (jj < 16) ? (x * cs - partner * sn) : (x * cs + partner * sn);
}

DI void mla_e1(const Params& P, int l) {
  u16* PC = (u16*)(P.ws + OFF_BIG);
  const int tid_ = otid(), lane = tid_ & 63, w = tid_ >> 6;
  const float* qan = P.in[24] + l * 256; const float* kvn = P.in[26] + l * 128; const float* krn = P.in[31] + l * 64;
  for (int row = blockIdx.x * 8 + w; row < RA; row += gridDim.x * 8) {
    u16* pr = PC + (size_t)row * 448;
    uint2 qa = *(const uint2*)(pr + lane * 4);
    unsigned kv = *(const unsigned*)(pr + 256 + lane * 2);
    float kr = bf2f(pr[384 + lane]);
    float q0 = blo(qa.x), q1 = bhi(qa.x), q2 = blo(qa.y), q3 = bhi(qa.y);
    float ssq = wave_sum(q0 * q0 + q1 * q1 + q2 * q2 + q3 * q3, lane);
    float rq = rsqrtf(ssq * (1.f / 256.f) + 1e-6f);
    float k0 = blo(kv), k1 = bhi(kv);
    float ssk = wave_sum(k0 * k0 + k1 * k1, lane);
    float rk = rsqrtf(ssk * (1.f / 128.f) + 1e-6f);
    float ssr = wave_sum(kr * kr, lane);
    float rr = rsqrtf(ssr * (1.f / 64.f) + 1e-6f);
    *(uint2*)(pr + lane * 4) = uint2{pack2(q0 * rq * qan[lane * 4], q1 * rq * qan[lane * 4 + 1]), pack2(q2 * rq * qan[lane * 4 + 2], q3 * rq * qan[lane * 4 + 3])};
    *(unsigned*)(pr + 256 + lane * 2) = pack2(k0 * rk * kvn[lane * 2], k1 * rk * kvn[lane * 2 + 1]);
    float x = kr * rr * krn[lane];
    if (row < RL) x = axial_rope_lane(x, lane, row & 8191);
    pr[384 + lane] = f2bf(x);
  }
}

DI void mla_e2(const Params& P, int l) {
  const u16* PC = (const u16*)(P.ws + OFF_BIG);
  u16* Q = (u16*)(P.ws + OFF_BIG + BIG_Q);
  u16* K = (u16*)(P.ws + OFF_BIG + BIG_K);
  const int tid_ = otid(), lane = tid_ & 63, w = tid_ >> 6;
  const float* qnn = P.in[28] + l * 128; const float* qrn = P.in[29] + l * 64; const float* knn = P.in[30] + l * 128;
  const float qscale = 0.07216878364870322f * 1.4426950408889634f;
  for (int row = blockIdx.x * 8 + w; row < RA; row += gridDim.x * 8) {
    u16 krr = PC[(size_t)row * 448 + 384 + lane];
    for (int h = 0; h < 4; ++h) {
      u16* qp = Q + (size_t)row * 768 + h * 192;
      unsigned qn = *(const unsigned*)(qp + lane * 2);
      float qr = bf2f(qp[128 + lane]);
      float a0 = blo(qn), a1 = bhi(qn);
      float r1 = rsqrtf(wave_sum(a0 * a0 + a1 * a1, lane) * (1.f / 128.f) + 1e-6f);
      float r2 = rsqrtf(wave_sum(qr * qr, lane) * (1.f / 64.f) + 1e-6f);
      *(unsigned*)(qp + lane * 2) = pack2(a0 * r1 * qnn[lane * 2] * qscale, a1 * r1 * qnn[lane * 2 + 1] * qscale);
      float x = qr * r2 * qrn[lane];
      if (row < RL) x = axial_rope_lane(x, lane, row & 8191);
      qp[128 + lane] = f2bf(x * qscale);
      u16* kp = K + (size_t)row * 768 + h * 192;
      unsigned kn = *(const unsigned*)(kp + lane * 2);
      float b0 = blo(kn), b1 = bhi(kn);
      float r3 = rsqrtf(wave_sum(b0 * b0 + b1 * b1, lane) * (1.f / 128.f) + 1e-6f);
      *(unsigned*)(kp + lane * 2) = pack2(b0 * r3 * knn[lane * 2], b1 * r3 * knn[lane * 2 + 1]);
      kp[128 + lane] = krr;
    }
  }
}

DI void attn_phase(const Params& P, bool with_ctx_queries, unsigned char* smem) {
  const u16* Q = (const u16*)(P.ws + OFF_BIG + BIG_Q);
  const u16* K = (const u16*)(P.ws + OFF_BIG + BIG_K);
  const u16* VT = (const u16*)(P.ws + OFF_BIG + BIG_VT);
  u16* YC = (u16*)(P.ws + OFF_YC);
  const int tid = otid(), lane = tid & 63, w = tid >> 6, ql = lane & 31, half = lane >> 5;
  const int nitems = 512 + (with_ctx_queries ? 16 : 0);
  for (int it = blockIdx.x; it < nitems; it += gridDim.x) {
    int b, h, qrow0, kt0;
    if (it < 512) { b = it >> 7; h = (it >> 5) & 3; qrow0 = b * 8192 + (it & 31) * 256; kt0 = 0; }
    else { int i2 = it - 512; b = i2 >> 2; h = i2 & 3; qrow0 = RL + b * 256; kt0 = 128; }
    const int qrow = qrow0 + w * 32 + ql;
    bf16x8 qf[12];
    {
      const u16* qp = Q + (size_t)qrow * 768 + h * 192 + half * 8;
#pragma unroll
      for (int ks = 0; ks < 12; ++ks) qf[ks] = *(const bf16x8*)(qp + ks * 16);
    }
    f32x16 O[4];
#pragma unroll
    for (int dt = 0; dt < 4; ++dt)
#pragma unroll
      for (int i = 0; i < 16; ++i) O[dt][i] = 0.f;
    float m_run = -1e30f, l_run = 0.f;
    uint4 pre0, pre1, pre2, pre3, pre4;
#define ATT_GLOAD(KT) do { const int kt_ = (KT); \
      const int krow0 = kt_ < 128 ? b * 8192 + kt_ * 64 : RL + b * 256 + (kt_ - 128) * 64; \
      const u16* kp_ = K + (size_t)(krow0 + (tid >> 3)) * 768 + h * 192 + (tid & 7) * 8; \
      pre0 = *(const uint4*)(kp_); pre1 = *(const uint4*)(kp_ + 64); pre2 = *(const uint4*)(kp_ + 128); \
      const u16* vb_ = VT + ((size_t)(b * 132 + kt_) * 4 + h) * 8192 + tid * 16; \
      pre3 = *(const uint4*)(vb_); pre4 = *(const uint4*)(vb_ + 8); } while (0)
#define ATT_SSTORE(BUF) do { unsigned char* kb_ = smem + (BUF) * 43008 + (tid >> 3) * 400 + (tid & 7) * 16; \
      *(uint4*)(kb_) = pre0; *(uint4*)(kb_ + 128) = pre1; *(uint4*)(kb_ + 256) = pre2; \
      unsigned char* vb2_ = smem + (BUF) * 43008 + 25600 + (tid >> 2) * 136 + (tid & 3) * 32; \
      *(uint4*)(vb2_) = pre3; *(uint4*)(vb2_ + 16) = pre4; } while (0)
    __syncthreads();
    ATT_GLOAD(kt0); ATT_SSTORE(0);
    __syncthreads();
    for (int kt = kt0; kt < 132; ++kt) {
      const bool more = kt + 1 < 132;
      if (more) ATT_GLOAD(kt + 1);
      const unsigned char* kb = smem + ((kt - kt0) & 1) * 43008;
      const unsigned char* vb = kb + 25600;
      f32x16 S[2];
#pragma unroll
      for (int mt = 0; mt < 2; ++mt)
#pragma unroll
        for (int i = 0; i < 16; ++i) S[mt][i] = 0.f;
#define KFRAG(KS, MT) (*(const bf16x8*)(kb + ((MT) * 32 + ql) * 400 + ((KS) * 16 + half * 8) * 2))
      bf16x8 ka0 = KFRAG(0, 0), ka1 = KFRAG(0, 1), kc0, kc1;
      __builtin_amdgcn_sched_barrier(0);
#pragma unroll
      for (int ks = 0; ks < 12; ks += 2) {
        kc0 = KFRAG(ks + 1, 0); kc1 = KFRAG(ks + 1, 1);
        __builtin_amdgcn_sched_barrier(0);
        S[0] = __builtin_amdgcn_mfma_f32_32x32x16_bf16(ka0, qf[ks], S[0], 0, 0, 0);
        S[1] = __builtin_amdgcn_mfma_f32_32x32x16_bf16(ka1, qf[ks], S[1], 0, 0, 0);
        __builtin_amdgcn_sched_barrier(0);
        if (ks + 2 < 12) { ka0 = KFRAG(ks + 2, 0); ka1 = KFRAG(ks + 2, 1); }
        __builtin_amdgcn_sched_barrier(0);
        S[0] = __builtin_amdgcn_mfma_f32_32x32x16_bf16(kc0, qf[ks + 1], S[0], 0, 0, 0);
        S[1] = __builtin_amdgcn_mfma_f32_32x32x16_bf16(kc1, qf[ks + 1], S[1], 0, 0, 0);
        __builtin_amdgcn_sched_barrier(0);
      }
#undef KFRAG
      float mx = S[0][0];
#pragma unroll
      for (int i = 1; i < 16; ++i) mx = fmaxf(mx, S[0][i]);
#pragma unroll
      for (int i = 0; i < 16; ++i) mx = fmaxf(mx, S[1][i]);
      mx = fmaxf(mx, shx(mx, 32, lane));
      const float m_new = fmaxf(m_run, mx);
      const float alpha = __builtin_amdgcn_exp2f(m_run - m_new);
      m_run = m_new;
      float ps = 0.f;
#pragma unroll
      for (int mt = 0; mt < 2; ++mt)
#pragma unroll
        for (int i = 0; i < 16; ++i) { float p = __builtin_amdgcn_exp2f(S[mt][i] - m_new); S[mt][i] = p; ps += p; }
      l_run = l_run * alpha + ps;
      if (__builtin_amdgcn_ballot_w64(alpha != 1.f) != 0) {
#pragma unroll
        for (int dt = 0; dt < 4; ++dt)
#pragma unroll
          for (int i = 0; i < 16; ++i) O[dt][i] *= alpha;
      }
#pragma unroll
      for (int mt = 0; mt < 2; ++mt) {
#pragma unroll
        for (int sp = 0; sp < 2; ++sp) {
          uint4 pk;
          pk.x = pack2(S[mt][8 * sp + 0], S[mt][8 * sp + 1]);
          pk.y = pack2(S[mt][8 * sp + 2], S[mt][8 * sp + 3]);
          pk.z = pack2(S[mt][8 * sp + 4], S[mt][8 * sp + 5]);
          pk.w = pack2(S[mt][8 * sp + 6], S[mt][8 * sp + 7]);
          const bf16x8 pb = __builtin_bit_cast(bf16x8, pk);
          const int k1 = mt * 32 + 16 * sp + 4 * half;
#pragma unroll
          for (int dt = 0; dt < 4; ++dt) {
            const unsigned char* vp = vb + (dt * 32 + ql) * 136 + k1 * 2;
            uint2 lo = *(const uint2*)vp;
            uint2 hi = *(const uint2*)(vp + 16);
            const bf16x8 a = __builtin_bit_cast(bf16x8, uint4{lo.x, lo.y, hi.x, hi.y});
            O[dt] = __builtin_amdgcn_mfma_f32_32x32x16_bf16(a, pb, O[dt], 0, 0, 0);
          }
        }
      }
      if (more) ATT_SSTORE((kt + 1 - kt0) & 1);
      __syncthreads();
    }
    const float lt = l_run + shx(l_run, 32, lane);
    const float inv = 1.f / lt;
    u16* yp = YC + (size_t)qrow * 512 + h * 128;
#pragma unroll
    for (int dt = 0; dt < 4; ++dt)
#pragma unroll
      for (int g = 0; g < 4; ++g) {
        const int dv = dt * 32 + 8 * g + 4 * half;
        *(uint2*)(yp + dv) = uint2{pack2(O[dt][4 * g] * inv, O[dt][4 * g + 1] * inv), pack2(O[dt][4 * g + 2] * inv, O[dt][4 * g + 3] * inv)};
      }
  }
}

DI void ffn_phases(const Params& P, GBar& grid, int l, int f, int nr, unsigned char* smem) {
  u16* WB = (u16*)(P.ws + OFF_WB);
  u16* HB = (u16*)(P.ws + OFF_HB);
  u16* BIG = (u16*)(P.ws + OFF_BIG);
  const u16* W13 = WB + (f == 0 ? W_13A : W_13B);
  const u16* W2 = WB + (f == 0 ? W_2A : W_2B);
  const int gidx = f == 0 ? 2 : 8;
  gemm_phase2(HB, 1024, W13, 1024, 1024, nr, 5632, smem, [&](f32x4 (&acc)[8][4], int rbase, int cbase) {
#pragma unroll
    for (int ct = 0; ct < 8; ct += 2)
#pragma unroll
      for (int tt = 0; tt < 4; ++tt) {
        const int row = rbase + tt * 16;
        const int fq4 = cbase & 12;
        const int j = ((cbase - fq4 + ct * 16) >> 1) + fq4;
        f32x4 a = acc[ct][tt], b = acc[ct + 1][tt];
        *(uint2*)(BIG + (size_t)row * 2816 + j) = uint2{pack2(siluf(a[0]) * b[0], siluf(a[1]) * b[1]), pack2(siluf(a[2]) * b[2], siluf(a[3]) * b[3])};
      }
  });
  grid.sync();
  gemm_phase(BIG, 2816, W2, 2816, 2816, nr, 1024, smem, [&](f32x4 (&acc)[4][4], int rbase, int cbase) {
    float4 g[4];
    const float* mdp = modp(P, l, rbase) + gidx * 1024 + cbase;
#pragma unroll
    for (int ct = 0; ct < 4; ++ct) g[ct] = *(const float4*)(mdp + ct * 16);
#pragma unroll
    for (int tt = 0; tt < 4; ++tt) {
      float4* xp = (float4*)(xrow(P, rbase + tt * 16) + cbase);
      float4 xv[4];
#pragma unroll
      for (int ct = 0; ct < 4; ++ct) xv[ct] = xp[ct * 4];
      __builtin_amdgcn_sched_barrier(0);
#pragma unroll
      for (int ct = 0; ct < 4; ++ct) {
        xv[ct].x += 0.5f * g[ct].x * acc[ct][tt][0]; xv[ct].y += 0.5f * g[ct].y * acc[ct][tt][1];
        xv[ct].z += 0.5f * g[ct].z * acc[ct][tt][2]; xv[ct].w += 0.5f * g[ct].w * acc[ct][tt][3];
      }
#pragma unroll
      for (int ct = 0; ct < 4; ++ct) xp[ct * 4] = xv[ct];
    }
  });
  grid.sync();
}


__global__ void __launch_bounds__(NTHR) fwd_megakernel(Params P) {
  extern __shared__ __attribute__((aligned(16))) unsigned char smem[];
  cg::grid_group cgrid = cg::this_grid();
  GBar grid; grid.bar = (unsigned*)(P.ws + OFF_BAR); grid.post();
  u16* WB = (u16*)(P.ws + OFF_WB);
  u16* HB = (u16*)(P.ws + OFF_HB);
  u16* BIG = (u16*)(P.ws + OFF_BIG);
  u16* YA = (u16*)(P.ws + OFF_YA);
  u16* YB = (u16*)(P.ws + OFF_YB);
  u16* YC = (u16*)(P.ws + OFF_YC);

  mods_phase(P, smem);
  convert_phase(P, 0, smem);
  hid3_phase(P, 0, smem);
  cgrid.sync();
  grid.census();

  for (int l = 0; l < 2; ++l) {
    const int nrows2 = (l == 0) ? RA : RL;
    norm_phase(P, l, 0, RA, l == 0);
    if (l == 1) { convert_phase(P, 1, smem); hid3_phase(P, 1, smem); }
    grid.sync();
    ffn_phases(P, grid, l, 0, RA, smem);
    {

      norm_phase(P, l, 1, RA, false);
      grid.sync();
      gemm_phase2(HB, 1024, WB + W_IN, 1024, 1024, RA, 2560, smem, [&](f32x4 (&acc)[8][4], int rbase, int cbase) {
#pragma unroll
        for (int ct = 0; ct < 8; ++ct)
#pragma unroll
          for (int tt = 0; tt < 4; ++tt) {
            const int row = rbase + tt * 16, col = cbase + ct * 16;
            *(uint2*)(BIG + (size_t)row * 2560 + col) = uint2{pack2(acc[ct][tt][0], acc[ct][tt][1]), pack2(acc[ct][tt][2], acc[ct][tt][3])};
          }
      });
      grid.sync();
      hgrn_h1(P, l, smem);
      grid.sync();
      hgrn_h2(P, smem);
      grid.sync();
      hgrn_h3(P, l, nrows2);
      grid.sync();
      gemm_phase<true>(HB, 1024, WB + W_IN + (size_t)2560 * 1024, 1024, 1024, RA, 1536, smem, [&](f32x4 (&acc)[4][4], int rbase, int cbase) {
#pragma unroll
        for (int ct = 0; ct < 4; ++ct)
#pragma unroll
          for (int tt = 0; tt < 4; ++tt) {
            const int row = rbase + tt * 16, col = cbase + ct * 16;
            u16* dst = row < RL ? BIG + ((size_t)((row >> 13) * 1536 + col) << 13) + (row & 8191)
                                : BIG + (size_t)4 * 1536 * 8192 + ((size_t)(((row - RL) >> 8) * 1536 + col) << 8) + (row & 255);
            *(uint2*)dst = uint2{pack2(acc[ct][tt][0], acc[ct][tt][1]), pack2(acc[ct][tt][2], acc[ct][tt][3])};
          }
      });
      grid.sync();
      hyena_phase(P, l, smem);
      if (l == 0) hyena_ctx_phase(P, l, smem);
      grid.sync();
      gemm_phase(HB, 1024, WB + W_IN + (size_t)4096 * 1024, 1024, 1024, RA, 448, smem, [&](f32x4 (&acc)[4][4], int rbase, int cbase) {
#pragma unroll
        for (int ct = 0; ct < 4; ++ct)
#pragma unroll
          for (int tt = 0; tt < 4; ++tt) {
            const int row = rbase + tt * 16, col = cbase + ct * 16;
            if (col < 448) *(uint2*)(BIG + (size_t)row * 448 + col) = uint2{pack2(acc[ct][tt][0], acc[ct][tt][1]), pack2(acc[ct][tt][2], acc[ct][tt][3])};
          }
      });
      grid.sync();
      mla_e1(P, l);
      grid.sync();
      {
        u16* Qb = (u16*)(P.ws + OFF_BIG + BIG_Q);
        u16* Kb = (u16*)(P.ws + OFF_BIG + BIG_K);
        u16* Vb = (u16*)(P.ws + OFF_BIG + BIG_VT);
        gemm_phase(BIG, 448, WB + W_UQ, 256, 256, RA, 768, smem, [&](f32x4 (&acc)[4][4], int rbase, int cbase) {
#pragma unroll
          for (int ct = 0; ct < 4; ++ct)
#pragma unroll
            for (int tt = 0; tt < 4; ++tt) {
              const int row = rbase + tt * 16, col = cbase + ct * 16;
              *(uint2*)(Qb + (size_t)row * 768 + col) = uint2{pack2(acc[ct][tt][0], acc[ct][tt][1]), pack2(acc[ct][tt][2], acc[ct][tt][3])};
            }
        });
        gemm_phase(BIG + 256, 448, WB + W_UKV, 128, 128, RA, 512, smem, [&](f32x4 (&acc)[4][4], int rbase, int cbase) {
#pragma unroll
          for (int ct = 0; ct < 4; ++ct)
#pragma unroll
            for (int tt = 0; tt < 4; ++tt) {
              const int row = rbase + tt * 16, col = cbase + ct * 16;
              const int hh = col >> 8, jj = col & 255;
              *(uint2*)(Kb + (size_t)row * 768 + hh * 192 + jj) = uint2{pack2(acc[ct][tt][0], acc[ct][tt][1]), pack2(acc[ct][tt][2], acc[ct][tt][3])};
            }
        }, 2, 0);
        gemm_phase<true>(BIG + 256, 448, WB + W_UKV, 128, 128, RA, 512, smem, [&](f32x4 (&acc)[4][4], int rbase, int cbase) {
#pragma unroll
          for (int ct = 0; ct < 4; ++ct)
#pragma unroll
            for (int tt = 0; tt < 4; ++tt) {
              const int row = rbase + tt * 16, col = cbase + ct * 16;
              const int hh = col >> 8, dv = (col & 255) - 128;
              int bb, kt;
              if (row < RL) { bb = row >> 13; kt = (row & 8191) >> 6; } else { int rc = row - RL; bb = rc >> 8; kt = 128 + ((rc & 255) >> 6); }
              u16* vp = Vb + (((size_t)(bb * 132 + kt) * 4 + hh) * 128 + dv) * 64 + (row & 63);
              *(uint2*)vp = uint2{pack2(acc[ct][tt][0], acc[ct][tt][1]), pack2(acc[ct][tt][2], acc[ct][tt][3])};
            }
        }, 2, 1);
      }
      grid.sync();
      mla_e2(P, l);
      grid.sync();
      attn_phase(P, l == 0, smem);
      grid.sync();
      gemm_phase2(HB, 1024, WB + W_IN + (size_t)4544 * 1024, 1024, 1024, nrows2, 3072, smem, [&](f32x4 (&acc)[8][4], int rbase, int cbase) {
#pragma unroll
        for (int ct = 0; ct < 8; ++ct)
#pragma unroll
          for (int tt = 0; tt < 4; ++tt) {
            const int row = rbase + tt * 16, col = cbase + ct * 16;
            *(uint2*)(BIG + (size_t)row * 3072 + col) = uint2{pack2(sigmf(acc[ct][tt][0]), sigmf(acc[ct][tt][1])), pack2(sigmf(acc[ct][tt][2]), sigmf(acc[ct][tt][3]))};
          }
      });
      grid.sync();
      {
        const int ntm = nrows2 >> 8;
        const int tid_ = otid(), lane = tid_ & 63, w = tid_ >> 6, wt = w & 3, wc = w >> 2;
        const TileIter ti(ntm, 8);
        for (int i = 0; i < ti.ntot_it; ++i) {
          int rt_, ct_;
          ti.get(i, rt_, ct_);
          const int row0 = rt_ * 256, col0 = ct_ * 128;
          const int rbase = row0 + wt * 64 + (lane & 15), cbase = col0 + wc * 64 + (lane >> 4) * 4;
          for (int x = 0; x < 3; ++x) {
            f32x4 acc[4][4];
            zero_acc(acc);
            const u16* Yx = x == 0 ? YA : x == 1 ? YB : YC;
            gemm_main(acc, Yx, 512, WB + W_BRA + (size_t)x * 524288, 512, 512, row0, col0, smem);
#pragma unroll
            for (int tt = 0; tt < 4; ++tt) {
              const int row = rbase + tt * 16;
              const u16* gp = BIG + (size_t)row * 3072 + x * 1024 + cbase;
              uint2* mp = (uint2*)(HB + (size_t)row * 1024 + cbase);
              uint2 g[4], o[4];
#pragma unroll
              for (int ct = 0; ct < 4; ++ct) { g[ct] = *(const uint2*)(gp + ct * 16); o[ct] = x > 0 ? mp[ct * 4] : uint2{0u, 0u}; }
              __builtin_amdgcn_sched_barrier(0);
#pragma unroll
              for (int ct = 0; ct < 4; ++ct) {
                const float m0 = blo(g[ct].x) * acc[ct][tt][0] + blo(o[ct].x), m1 = bhi(g[ct].x) * acc[ct][tt][1] + bhi(o[ct].x);
                const float m2 = blo(g[ct].y) * acc[ct][tt][2] + blo(o[ct].y), m3 = bhi(g[ct].y) * acc[ct][tt][3] + bhi(o[ct].y);
                g[ct] = uint2{pack2(m0, m1), pack2(m2, m3)};
              }
#pragma unroll
              for (int ct = 0; ct < 4; ++ct) mp[ct * 4] = g[ct];
            }
          }
        }
      }
      grid.sync();
      gemm_phase(HB, 1024, WB + W_OUT, 1024, 1024, nrows2, 1024, smem, [&](f32x4 (&acc)[4][4], int rbase, int cbase) {
        float4 g[4];
        const float* mdp = modp(P, l, rbase) + 5 * 1024 + cbase;
#pragma unroll
        for (int ct = 0; ct < 4; ++ct) g[ct] = *(const float4*)(mdp + ct * 16);
#pragma unroll
        for (int tt = 0; tt < 4; ++tt) {
          float4* xp = (float4*)(xrow(P, rbase + tt * 16) + cbase);
          float4 xv[4];
#pragma unroll
          for (int ct = 0; ct < 4; ++ct) xv[ct] = xp[ct * 4];
          __builtin_amdgcn_sched_barrier(0);
#pragma unroll
          for (int ct = 0; ct < 4; ++ct) {
            xv[ct].x += g[ct].x * acc[ct][tt][0]; xv[ct].y += g[ct].y * acc[ct][tt][1];
            xv[ct].z += g[ct].z * acc[ct][tt][2]; xv[ct].w += g[ct].w * acc[ct][tt][3];
          }
#pragma unroll
          for (int ct = 0; ct < 4; ++ct) xp[ct * 4] = xv[ct];
        }
      });
      grid.sync();
    }
    norm_phase(P, l, 2, nrows2, false);
    grid.sync();
    ffn_phases(P, grid, l, 1, nrows2, smem);
  }
}

extern "C" void kernel_launch(void* const* d_in, const int* in_sizes, int n_in, void* d_out, int out_size, void* d_ws, size_t ws_size,
                              hipStream_t stream) {
  static int grid_blocks = 0;
  if (!grid_blocks) {
    int dev = 0, cus = 0, per_cu = 0;
    hipGetDevice(&dev);
    hipDeviceGetAttribute(&cus, hipDeviceAttributeMultiprocessorCount, dev);
    hipFuncSetAttribute((const void*)fwd_megakernel, hipFuncAttributeMaxDynamicSharedMemorySize, LDS_BYTES);
    hipOccupancyMaxActiveBlocksPerMultiprocessor(&per_cu, (const void*)fwd_megakernel, NTHR, LDS_BYTES);
    if (per_cu < 1) { fprintf(stderr, "occupancy query says %d blocks/CU\n", per_cu); per_cu = 1; }
    grid_blocks = (cus & ~7);
    if (ws_size < WS_NEED) fprintf(stderr, "workspace too small: %zu < %zu\n", ws_size, (size_t)WS_NEED);
  }
  Params p{};
  for (int i = 0; i < 39; ++i) p.in[i] = (const float*)d_in[i];
  p.out = (float*)d_out;
  p.ws = (unsigned char*)d_ws;
  (void)hipMemsetAsync((unsigned char*)d_ws + OFF_BAR, 0, 16384, stream);
  void* args[] = {&p};
  hipError_t e = hipLaunchCooperativeKernel((const void*)fwd_megakernel, dim3(grid_blocks), dim3(NTHR), args, LDS_BYTES, stream);
  if (e != hipSuccess) fprintf(stderr, "cooperative launch failed: %s (grid %d)\n", hipGetErrorString(e), grid_blocks);
}
```

```cpp
#include <hip/hip_runtime.h>
#include <hip/hip_cooperative_groups.h>
#include <cstdio>
namespace cg = cooperative_groups;

#define DI __device__ __forceinline__
typedef unsigned short u16;
typedef __attribute__((ext_vector_type(8))) short bf16x8;
typedef __attribute__((ext_vector_type(4))) float f32x4;
typedef __attribute__((ext_vector_type(16))) float f32x16;

constexpr int NTHR = 512;
constexpr int RL = 32768, RA = 33792;
constexpr int LDS_BYTES = 151552;

constexpr size_t OFF_MODS = 0;
constexpr size_t OFF_XC   = OFF_MODS + 368640;
constexpr size_t OFF_HID3 = OFF_XC + 4194304;
constexpr size_t OFF_DEC  = OFF_HID3 + 2162688;
constexpr size_t OFF_TW   = OFF_DEC + 2162688;
constexpr size_t OFF_BAR  = OFF_TW + 65536;
constexpr size_t OFF_WB   = OFF_BAR + 16384;
constexpr size_t OFF_HB   = OFF_WB + 56098816;
constexpr size_t OFF_YA   = OFF_HB + 69206016;
constexpr size_t OFF_YB   = OFF_YA + 34603008;
constexpr size_t OFF_YC   = OFF_YB + 34603008;
constexpr size_t OFF_BIG  = OFF_YC + 34603008;
constexpr size_t BIG_FSCR = 104857600;
constexpr size_t BIG_Q    = 30277632;
constexpr size_t BIG_K    = BIG_Q + 51904512;
constexpr size_t BIG_VT   = BIG_K + 51904512;
constexpr size_t WS_NEED  = OFF_BIG + 207618048;
constexpr int W_13A = 0, W_2A = 5767168, W_IN = 8650752, W_UQ = 16449536, W_UKV = 16646144, W_BRA = 16777216,
              W_BRB = 17301504, W_BRC = 17825792, W_OUT = 18350080, W_13B = 19398656, W_2B = 25165824;

struct Params { const float* in[39]; float* out; unsigned char* ws; };

DI int otid() { int t = __builtin_amdgcn_workitem_id_x(); asm volatile("" : "+v"(t)); return t; }
typedef float f32x2_t __attribute__((ext_vector_type(2)));
typedef __bf16 bf16x2_t __attribute__((ext_vector_type(2)));
DI unsigned pack2(float a, float b) { f32x2_t v = {a, b}; bf16x2_t r = __builtin_convertvector(v, bf16x2_t); return __builtin_bit_cast(unsigned, r); }
DI u16 f2bf(float x) { return (u16)(pack2(x, x) & 0xffffu); }
DI float bf2f(u16 h) { return __uint_as_float(((unsigned)h) << 16); }
DI float blo(unsigned u) { return __uint_as_float(u << 16); }
DI float bhi(unsigned u) { return __uint_as_float(u & 0xffff0000u); }
DI float siluf(float x) { return x * __builtin_amdgcn_rcpf(1.f + __expf(-x)); }
DI float sigmf(float x) { return __builtin_amdgcn_rcpf(1.f + __expf(-x)); }
DI float shx(float v, int mask, int lane) { return __int_as_float(__builtin_amdgcn_ds_bpermute((lane ^ mask) << 2, __float_as_int(v))); }
DI float row16_sum(float v) {
  v += __int_as_float(__builtin_amdgcn_update_dpp(0, __float_as_int(v), 0xB1, 0xF, 0xF, true));
  v += __int_as_float(__builtin_amdgcn_update_dpp(0, __float_as_int(v), 0x4E, 0xF, 0xF, true));
  v += __int_as_float(__builtin_amdgcn_update_dpp(0, __float_as_int(v), 0x141, 0xF, 0xF, true));
  v += __int_as_float(__builtin_amdgcn_update_dpp(0, __float_as_int(v), 0x140, 0xF, 0xF, true));
  return v;
}
DI float wave_sum(float v, int lane) {
  (void)lane;
  v = row16_sum(v);
  const int iv = __float_as_int(v);
  return __int_as_float(__builtin_amdgcn_readlane(iv, 0)) + __int_as_float(__builtin_amdgcn_readlane(iv, 16)) +
         __int_as_float(__builtin_amdgcn_readlane(iv, 32)) + __int_as_float(__builtin_amdgcn_readlane(iv, 48));
}
DI float* xrow(const Params& P, int r) { return r < RL ? P.out + (size_t)r * 1024 : (float*)(P.ws + OFF_XC) + (size_t)(r - RL) * 1024; }
DI const float* modp(const Params& P, int l, int r) { int mi = r < RL ? (r >> 13) : 4; return (const float*)(P.ws + OFF_MODS) + (size_t)(l * 5 + mi) * 9216; }
DI float block_sum(float v, float* red) {
  const int t_ = otid();
  v = wave_sum(v, t_ & 63);
  __syncthreads();
  if ((t_ & 63) == 0) red[t_ >> 6] = v;
  __syncthreads();
  float s = 0.f;
  for (int i = 0; i < 8; ++i) s += red[i];
  return s;
}

#define XB_XCNT(j) (256 + 64 * (j))
#define XB_XSUB(j) (1280 + 64 * (j))
#define XB_XGEN(j) (2304 + 64 * (j))
#define XB_TOP 3328
#define XB_TOPGEN 3392
DI unsigned xb_ld(unsigned* p) { return __hip_atomic_load(p, __ATOMIC_RELAXED, __HIP_MEMORY_SCOPE_AGENT); }
DI unsigned xb_add(unsigned* p, unsigned v) { return __hip_atomic_fetch_add(p, v, __ATOMIC_RELAXED, __HIP_MEMORY_SCOPE_AGENT); }
DI unsigned xb_xcc_id() { return (unsigned)__builtin_amdgcn_s_getreg((3 << 11) | 20) & 0xFu; }
struct GBar {
  unsigned* bar; unsigned x, nloc, nx, gen;
  DI void post() { x = xb_xcc_id(); if (__builtin_amdgcn_workitem_id_x() == 0) (void)xb_add(&bar[XB_XCNT(x)], 1u); }
  DI void census() {
    unsigned mine = 0, cnt = 0;
    for (unsigned j = 0; j < 16; ++j) { const unsigned c = xb_ld(&bar[XB_XCNT(j)]); cnt += c > 0u ? 1u : 0u; mine = j == x ? c : mine; }
    nloc = __builtin_amdgcn_readfirstlane(mine > 0u ? mine : 1u); nx = __builtin_amdgcn_readfirstlane(cnt > 0u ? cnt : 1u); gen = 0;
  }
  DI void sync() {
    asm volatile("s_waitcnt vmcnt(0)" ::: "memory");
    __syncthreads();
    if (__builtin_amdgcn_workitem_id_x() == 0) {
      __builtin_amdgcn_s_waitcnt(0);
      const unsigned old = xb_add(&bar[XB_XSUB(x)], 1u);
      if (old + 1u == (gen + 1u) * nloc) {
        __builtin_amdgcn_fence(__ATOMIC_RELEASE, "agent");
        asm volatile("s_waitcnt vmcnt(0)" ::: "memory");
        const unsigned og = xb_add(&bar[XB_TOP], 1u);
        if (og + 1u == (gen + 1u) * nx) xb_add(&bar[XB_TOPGEN], 1u);
        else { while (xb_ld(&bar[XB_TOPGEN]) == gen) __builtin_amdgcn_s_sleep(1); }
        __builtin_amdgcn_fence(__ATOMIC_ACQUIRE, "agent");
        xb_add(&bar[XB_XGEN(x)], 1u);
        asm volatile("s_waitcnt vmcnt(0)" ::: "memory");
      } else {
        while (xb_ld(&bar[XB_XGEN(x)]) == gen) __builtin_amdgcn_s_sleep(1);
        __builtin_amdgcn_fence(__ATOMIC_ACQUIRE, "agent");
        asm volatile("s_waitcnt vmcnt(0)" ::: "memory");
      }
    }
    gen += 1u;
    __syncthreads();
  }
};

DI void mods_phase(const Params& P, unsigned char* smem) {
  float* s = (float*)smem;
  const int tid = otid();
  {
    float2* TW = (float2*)(P.ws + OFF_TW);
    for (int k = blockIdx.x * NTHR + tid; k < 8192; k += gridDim.x * NTHR) {
      float sn, cs;
      sincospif((float)k * (1.f / 8192.f), &sn, &cs);
      TW[k] = float2{cs, -sn};
    }
  }
  for (int it = blockIdx.x; it < 36; it += gridDim.x) {
    const int l = it / 18, n = (it % 18) * 512 + tid;
    __syncthreads();
    for (int i = tid; i < 5120; i += NTHR) { float c = i < 4096 ? P.in[1][i] : P.in[3][i - 4096]; s[i] = siluf(c); }
    __syncthreads();
    float a0 = 0, a1 = 0, a2 = 0, a3 = 0, a4 = 0;
    const float* w = P.in[4] + (size_t)l * 1024 * 9216 + n;
#pragma unroll 8
    for (int k = 0; k < 1024; ++k) {
      float wv = w[(size_t)k * 9216];
      a0 += s[k] * wv; a1 += s[1024 + k] * wv; a2 += s[2048 + k] * wv; a3 += s[3072 + k] * wv; a4 += s[4096 + k] * wv;
    }
    float bb = P.in[5][l * 9216 + n];
    float* m = (float*)(P.ws + OFF_MODS) + (size_t)l * 5 * 9216 + n;
    m[0] = a0 + bb; m[9216] = a1 + bb; m[2 * 9216] = a2 + bb; m[3 * 9216] = a3 + bb; m[4 * 9216] = a4 + bb;
  }
}

DI void hid3_phase(const Params& P, int l, unsigned char* smem) {
  float* emb = (float*)smem;
  float* hA = emb + 64 * 33;
  float* hB = hA + 64 * 65;
  const int tid = otid(), p = tid & 63, fg = tid >> 6;
  const float* w1 = P.in[15] + l * 33 * 64; const float* b1 = P.in[16] + l * 64;
  const float* w2 = P.in[17] + l * 4096;    const float* b2 = P.in[18] + l * 64;
  const float* w3 = P.in[19] + l * 4096;    const float* b3 = P.in[20] + l * 64;
  const float* fr = P.in[22] + l * 64;
  u16* HID = (u16*)(P.ws + OFF_HID3);
  for (int it = blockIdx.x; it < 132; it += gridDim.x) {
    const int L = it < 128 ? 8192 : 256;
    const int pos0 = it < 128 ? it * 64 : (it - 128) * 64;
    u16* outp = HID + (size_t)(it < 128 ? pos0 : 8192 + pos0) * 64;
    __syncthreads();
    for (int e = tid; e < 64 * 33; e += NTHR) {
      int pp = e / 33, j = e % 33;
      float posf = (float)(pos0 + pp);
      float tl = posf / (float)(L - 1);
      float wang = (6.283185307179586f / (float)L) * posf;
      float v;
      if (j == 0) v = tl;
      else {
        int bi = (j - 1) & 15;
        float band = 1e-4f + (float)bi * ((15.f - 1e-4f) / 15.f);
        float ang = band * wang;
        v = (j <= 16) ? cosf(ang) : -sinf(ang);
      }
      emb[pp * 33 + j] = v;
    }
    __syncthreads();
    for (int ff = 0; ff < 8; ++ff) {
      int f = fg * 8 + ff; float a = b1[f];
      for (int j = 0; j < 33; ++j) a += emb[p * 33 + j] * w1[j * 64 + f];
      hA[p * 65 + f] = sinf(fr[f] * a);
    }
    __syncthreads();
    for (int ff = 0; ff < 8; ++ff) {
      int f = fg * 8 + ff; float a = b2[f];
      for (int j = 0; j < 64; ++j) a += hA[p * 65 + j] * w2[j * 64 + f];
      hB[p * 65 + f] = sinf(fr[f] * a);
    }
    __syncthreads();
    for (int ff = 0; ff < 8; ++ff) {
      int f = fg * 8 + ff; float a = b3[f];
      for (int j = 0; j < 64; ++j) a += hB[p * 65 + j] * w3[j * 64 + f];
      outp[p * 64 + f] = f2bf(sinf(fr[f] * a));
    }
  }
}

DI void conv_tile(const float* __restrict__ src, int K, int N, u16* __restrict__ dst, int tile, bool perm13, unsigned char* smem) {
  float* t = (float*)smem;
  const int tid = otid();
  const int ntn = N >> 6;
  const int k0 = (tile / ntn) * 64, n0 = (tile % ntn) * 64;
  __syncthreads();
  {
    int kk = tid >> 4, nn = (tid & 15) * 4;
    for (int it = 0; it < 2; ++it) {
      float4 v = *(const float4*)(src + (size_t)(k0 + kk + 32 * it) * N + n0 + nn);
      float* d = t + (kk + 32 * it) * 65 + nn;
      d[0] = v.x; d[1] = v.y; d[2] = v.z; d[3] = v.w;
    }
  }
  __syncthreads();
  {
    int nn = tid >> 3, kc = (tid & 7) * 8;
    int n = n0 + nn;
    if (perm13) { n = n < 2816 ? ((n >> 4) * 32 + (n & 15)) : (((n - 2816) >> 4) * 32 + 16 + ((n - 2816) & 15)); }
    uint4 o;
    o.x = pack2(t[(kc + 0) * 65 + nn], t[(kc + 1) * 65 + nn]);
    o.y = pack2(t[(kc + 2) * 65 + nn], t[(kc + 3) * 65 + nn]);
    o.z = pack2(t[(kc + 4) * 65 + nn], t[(kc + 5) * 65 + nn]);
    o.w = pack2(t[(kc + 6) * 65 + nn], t[(kc + 7) * 65 + nn]);
    *(uint4*)(dst + (size_t)n * K + k0 + kc) = o;
  }
}

DI void convert_phase(const Params& P, int l, unsigned char* smem) {
  u16* WB = (u16*)(P.ws + OFF_WB);
  for (int it = blockIdx.x; it < 6848; it += gridDim.x) {
    int i = it;
    if (i < 1408) { conv_tile(P.in[7] + (size_t)l * 1024 * 5632, 1024, 5632, WB + W_13A, i, true, smem); continue; } i -= 1408;
    if (i < 704)  { conv_tile(P.in[8] + (size_t)l * 2816 * 1024, 2816, 1024, WB + W_2A, i, false, smem); continue; } i -= 704;
    if (i < 1904) { conv_tile(P.in[10] + (size_t)l * 1024 * 7616, 1024, 7616, WB + W_IN, i, false, smem); continue; } i -= 1904;
    if (i < 48)   { conv_tile(P.in[25] + (size_t)l * 256 * 768, 256, 768, WB + W_UQ, i, false, smem); continue; } i -= 48;
    if (i < 32)   { conv_tile(P.in[27] + (size_t)l * 128 * 1024, 128, 1024, WB + W_UKV, i, false, smem); continue; } i -= 32;
    if (i < 128)  { conv_tile(P.in[32] + (size_t)l * 512 * 1024, 512, 1024, WB + W_BRA, i, false, smem); continue; } i -= 128;
    if (i < 128)  { conv_tile(P.in[33] + (size_t)l * 512 * 1024, 512, 1024, WB + W_BRB, i, false, smem); continue; } i -= 128;
    if (i < 128)  { conv_tile(P.in[34] + (size_t)l * 512 * 1024, 512, 1024, WB + W_BRC, i, false, smem); continue; } i -= 128;
    if (i < 256)  { conv_tile(P.in[35] + (size_t)l * 1024 * 1024, 1024, 1024, WB + W_OUT, i, false, smem); continue; } i -= 256;
    if (i < 1408) { conv_tile(P.in[37] + (size_t)l * 1024 * 5632, 1024, 5632, WB + W_13B, i, true, smem); continue; } i -= 1408;
    conv_tile(P.in[38] + (size_t)l * 2816 * 1024, 2816, 1024, WB + W_2B, i, false, smem);
  }
}

DI void norm_phase(const Params& P, int l, int which, int nrows, bool first) {
  const int tid_ = otid(), lane = tid_ & 63, w = tid_ >> 6;
  const float* gw = (which == 0 ? P.in[6] : which == 1 ? P.in[9] : P.in[36]) + l * 1024;
  u16* HB = (u16*)(P.ws + OFF_HB);
  for (int row = blockIdx.x * 8 + w; row < nrows; row += gridDim.x * 8) {
    float* xr = xrow(P, row);
    const float* src = first ? (row < RL ? P.in[0] + (size_t)row * 1024 : P.in[2] + (size_t)(row - RL) * 1024) : xr;
    float4 v[4];
    float ss = 0.f;
    for (int j = 0; j < 4; ++j) {
      { const f32x4 t_ = __builtin_nontemporal_load(((const f32x4*)src) + j * 64 + lane); v[j] = float4{t_[0], t_[1], t_[2], t_[3]}; }
      ss += v[j].x * v[j].x + v[j].y * v[j].y + v[j].z * v[j].z + v[j].w * v[j].w;
    }
    ss = wave_sum(ss, lane);
    float rstd = rsqrtf(ss * (1.f / 1024.f) + 1e-6f);
    const float* md = modp(P, l, row) + which * 3 * 1024;
    for (int j = 0; j < 4; ++j) {
      if (first) ((float4*)xr)[j * 64 + lane] = v[j];
      int col = (j * 64 + lane) * 4;
      float4 g = *(const float4*)(gw + col);
      float4 sh = *(const float4*)(md + col);
      float4 sc = *(const float4*)(md + 1024 + col);
      uint2 o;
      o.x = pack2(v[j].x * rstd * g.x * (1.f + sc.x) + sh.x, v[j].y * rstd * g.y * (1.f + sc.y) + sh.y);
      o.y = pack2(v[j].z * rstd * g.z * (1.f + sc.z) + sh.z, v[j].w * rstd * g.w * (1.f + sc.w) + sh.w);
      *(uint2*)(HB + (size_t)row * 1024 + col) = o;
    }
  }
}

#define LDSP(p) ((__attribute__((address_space(3))) unsigned*)(p))
#define GLBP(p) ((__attribute__((address_space(1))) const unsigned*)(p))
#define WAIT_VM(n) asm volatile("s_waitcnt vmcnt(" #n ")" ::: "memory")
#define RAW_BARRIER() do { asm volatile("s_waitcnt lgkmcnt(0)" ::: "memory"); __builtin_amdgcn_s_barrier(); asm volatile("" ::: "memory"); } while (0)

template <bool SWAP = false>
DI void gemm_main(f32x4 (&acc)[4][4], const u16* __restrict__ Act, int lda, const u16* __restrict__ Wt, int ldw, int K,
                  int row0, int col0, unsigned char* smem) {
  const int tid = otid(), lane = tid & 63, w = tid >> 6, wt = w & 3, wc = w >> 2;
  const int lr = tid >> 3, lc = (tid & 7) ^ ((lr >> 1) & 7);
  const u16* srcA = Act + (size_t)(row0 + lr) * lda + lc * 8;
  const u16* srcW = Wt + (size_t)(col0 + lr) * ldw + lc * 8;
  const int nk = K >> 6;
  const int fr = lane & 15, fq = lane >> 4, key = (fr >> 1) & 7;
  unsigned char* wbase = smem + w * 1024;
#define GM_DMA(KT, ST) do { const int k0_ = (KT) * 64; unsigned char* d_ = wbase + (ST) * 49152; \
    __builtin_amdgcn_global_load_lds(GLBP(srcA + k0_), LDSP(d_), 16, 0, 0); \
    __builtin_amdgcn_global_load_lds(GLBP(srcA + (size_t)64 * lda + k0_), LDSP(d_ + 8192), 16, 0, 0); \
    __builtin_amdgcn_global_load_lds(GLBP(srcA + (size_t)128 * lda + k0_), LDSP(d_ + 16384), 16, 0, 0); \
    __builtin_amdgcn_global_load_lds(GLBP(srcA + (size_t)192 * lda + k0_), LDSP(d_ + 24576), 16, 0, 0); \
    __builtin_amdgcn_global_load_lds(GLBP(srcW + k0_), LDSP(d_ + 32768), 16, 0, 0); \
    __builtin_amdgcn_global_load_lds(GLBP(srcW + (size_t)64 * ldw + k0_), LDSP(d_ + 40960), 16, 0, 0); } while (0)
#define GM_FRAGS(A_, B_, ST, KS) do { const unsigned char* base_ = smem + (ST) * 49152; const int po_ = (((KS) * 4 + fq) ^ key) * 16; \
    _Pragma("unroll") for (int ct = 0; ct < 4; ++ct) A_[ct] = *(const bf16x8*)(base_ + (256 + wc * 64 + ct * 16 + fr) * 128 + po_); \
    _Pragma("unroll") for (int tt = 0; tt < 4; ++tt) B_[tt] = *(const bf16x8*)(base_ + (wt * 64 + tt * 16 + fr) * 128 + po_); } while (0)
#define GM_MMA(A_, B_) do { \
    _Pragma("unroll") for (int ct = 0; ct < 4; ++ct) \
      _Pragma("unroll") for (int tt = 0; tt < 4; ++tt) \
        acc[ct][tt] = SWAP ? __builtin_amdgcn_mfma_f32_16x16x32_bf16(B_[tt], A_[ct], acc[ct][tt], 0, 0, 0) \
                           : __builtin_amdgcn_mfma_f32_16x16x32_bf16(A_[ct], B_[tt], acc[ct][tt], 0, 0, 0); } while (0)
  bf16x8 fa0[4], fb0[4], fa1[4], fb1[4];
  WAIT_VM(0);
  RAW_BARRIER();
  GM_DMA(0, 0);
  if (nk > 1) GM_DMA(1, 1);
  if (nk > 2) GM_DMA(2, 2);
  if (nk > 2) WAIT_VM(12); else if (nk > 1) WAIT_VM(6); else WAIT_VM(0);
  RAW_BARRIER();
  GM_FRAGS(fa0, fb0, 0, 0);
  int st = 0;
  for (int kt = 0; kt < nk; ++kt) {
    const int st1 = st == 2 ? 0 : st + 1;
    GM_FRAGS(fa1, fb1, st, 1);
    GM_MMA(fa0, fb0);
    if (kt + 1 < nk) {
      if (kt + 2 < nk) WAIT_VM(6); else WAIT_VM(0);
      RAW_BARRIER();
      if (kt + 3 < nk) GM_DMA(kt + 3, st);
      GM_FRAGS(fa0, fb0, st1, 0);
    }
    GM_MMA(fa1, fb1);
    st = st1;
  }
#undef GM_FRAGS
#undef GM_MMA
#undef GM_DMA
}

DI void zero_acc(f32x4 (&acc)[4][4]) {
#pragma unroll
  for (int a = 0; a < 4; ++a)
#pragma unroll
    for (int b = 0; b < 4; ++b) acc[a][b] = f32x4{0.f, 0.f, 0.f, 0.f};
}

struct TileIter {
  int ntn, nmain_it, ntot_it, x, slot, nslot, rem0;
  DI TileIter(int ntm, int ntn_) {
    ntn = ntn_;
    x = blockIdx.x & 7; slot = blockIdx.x >> 3; nslot = gridDim.x >> 3;
    const int nmain = (ntm >> 3) * ntn;
    rem0 = (ntm >> 3) << 3;
    const int nrem = (ntm - rem0) * ntn;
    nmain_it = slot < nmain ? (nmain - slot + nslot - 1) / nslot : 0;
    const int nrem_it = (int)blockIdx.x < nrem ? (nrem - (int)blockIdx.x + (int)gridDim.x - 1) / (int)gridDim.x : 0;
    ntot_it = nmain_it + nrem_it;
  }
  DI void get(int i, int& rt, int& ct) const {
    if (i < nmain_it) { const int q = slot + i * nslot; rt = (q / ntn) * 8 + x; ct = q % ntn; }
    else { const int j = blockIdx.x + (i - nmain_it) * gridDim.x; rt = rem0 + j / ntn; ct = j % ntn; }
  }
};

template <bool SWAP = false, class Epi>
DI void gemm_phase(const u16* Act, int lda, const u16* Wt, int ldw, int K, int Mrows, int Ncols, unsigned char* smem, Epi epi,
                   int ct_mul = 1, int ct_off = 0) {
  const int ntn = (Ncols + 127) >> 7, ntm = Mrows >> 8;
  const int tid_ = otid(), lane = tid_ & 63, w = tid_ >> 6, wt = w & 3, wc = w >> 2;
  const TileIter ti(ntm, ntn);
  for (int i = 0; i < ti.ntot_it; ++i) {
    int rt_, ct_;
    ti.get(i, rt_, ct_);
    const int row0 = rt_ * 256, col0 = (ct_ * ct_mul + ct_off) * 128;
    f32x4 acc[4][4];
    zero_acc(acc);
    gemm_main<SWAP>(acc, Act, lda, Wt, ldw, K, row0, col0, smem);
    const int rbase = row0 + wt * 64 + (SWAP ? (lane >> 4) * 4 : (lane & 15));
    const int cbase = col0 + wc * 64 + (SWAP ? (lane & 15) : (lane >> 4) * 4);
    epi(acc, rbase, cbase);
  }
}

DI void gemm_main2(f32x4 (&acc)[8][4], const u16* __restrict__ Act, int lda, const u16* __restrict__ Wt, int ldw, int K,
                   int row0, int col0, unsigned char* smem) {
  const int tid = otid(), lane = tid & 63, w = tid >> 6, wt = w & 3, wc = w >> 2;
  const int lr = tid >> 2, lc = (tid & 3) ^ ((lr >> 2) & 3);
  const u16* srcA = Act + (size_t)(row0 + lr) * lda + lc * 8;
  const u16* srcW = Wt + (size_t)(col0 + lr) * ldw + lc * 8;
  const int nk = K >> 5;
  const int fr = lane & 15, fq = lane >> 4;
  const int po = (fq ^ ((fr >> 2) & 3)) * 16;
  unsigned char* wbase = smem + w * 1024;
#define G2_DMA(KT, ST) do { const int k0_ = (KT) * 32; unsigned char* d_ = wbase + (ST) * 32768; \
    __builtin_amdgcn_global_load_lds(GLBP(srcA + k0_), LDSP(d_), 16, 0, 0); \
    __builtin_amdgcn_global_load_lds(GLBP(srcA + (size_t)128 * lda + k0_), LDSP(d_ + 8192), 16, 0, 0); \
    __builtin_amdgcn_global_load_lds(GLBP(srcW + k0_), LDSP(d_ + 16384), 16, 0, 0); \
    __builtin_amdgcn_global_load_lds(GLBP(srcW + (size_t)128 * ldw + k0_), LDSP(d_ + 24576), 16, 0, 0); } while (0)
  WAIT_VM(0);
  RAW_BARRIER();
  G2_DMA(0, 0);
  if (nk > 1) G2_DMA(1, 1);
  int st = 0;
  for (int kt = 0; kt < nk; ++kt) {
    if (kt + 1 < nk) WAIT_VM(4); else WAIT_VM(0);
    RAW_BARRIER();
    if (kt + 2 < nk) { const int s2 = st >= 1 ? st - 1 : 2; G2_DMA(kt + 2, s2); }
    const unsigned char* base = smem + st * 32768;
    __builtin_amdgcn_iglp_opt(1);
    bf16x8 a[8], b[4];
#pragma unroll
    for (int ct = 0; ct < 8; ++ct) a[ct] = *(const bf16x8*)(base + (256 + wc * 128 + ct * 16 + fr) * 64 + po);
#pragma unroll
    for (int tt = 0; tt < 4; ++tt) b[tt] = *(const bf16x8*)(base + (wt * 64 + tt * 16 + fr) * 64 + po);
#pragma unroll
    for (int ct = 0; ct < 8; ++ct)
#pragma unroll
      for (int tt = 0; tt < 4; ++tt) acc[ct][tt] = __builtin_amdgcn_mfma_f32_16x16x32_bf16(a[ct], b[tt], acc[ct][tt], 0, 0, 0);
    st = st == 2 ? 0 : st + 1;
  }
#undef G2_DMA
}

template <class Epi>
DI void gemm_phase2(const u16* Act, int lda, const u16* Wt, int ldw, int K, int Mrows, int Ncols, unsigned char* smem, Epi epi) {
  const int ntn = Ncols >> 8, ntm = Mrows >> 8;
  const int tid_ = otid(), lane = tid_ & 63, w = tid_ >> 6, wt = w & 3, wc = w >> 2;
  const TileIter ti(ntm, ntn);
  for (int i = 0; i < ti.ntot_it; ++i) {
    int rt_, ct_;
    ti.get(i, rt_, ct_);
    const int row0 = rt_ * 256, col0 = ct_ * 256;
    f32x4 acc[8][4];
#pragma unroll
    for (int a = 0; a < 8; ++a)
#pragma unroll
      for (int b = 0; b < 4; ++b) acc[a][b] = f32x4{0.f, 0.f, 0.f, 0.f};
    gemm_main2(acc, Act, lda, Wt, ldw, K, row0, col0, smem);
    epi(acc, row0 + wt * 64 + (lane & 15), col0 + wc * 128 + (lane >> 4) * 4);
  }
}

DI float lb_value(const Params& P, int dir, int l, int k) {
  if (l == 0) return 0.f;
  float a = P.in[11][(dir * 2 + 0) * 512 + k], b = P.in[11][(dir * 2 + 1) * 512 + k];
  float m = fmaxf(a, b);
  float ea = __expf(a - m), eb = __expf(b - m);
  return eb / (ea + eb);
}

DI void hgrn_h1(const Params& P, int l, unsigned char* smem) {
  u16* PA = (u16*)(P.ws + OFF_BIG);
  u16* YA = (u16*)(P.ws + OFF_YA);
  u16* OF = (u16*)(P.ws + OFF_YB);
  u16* OB = (u16*)(P.ws + OFF_YC);
  float* DEC = (float*)(P.ws + OFF_DEC);
  u16* sQF = (u16*)smem;
  u16* sKF = sQF + 64 * 136;
  u16* sQB = sKF + 64 * 136;
  u16* sKB = sQB + 64 * 136;
  u16* sVT = sKB + 64 * 136;
  u16* sAT = sVT + 128 * 72;
  float* ps = (float*)(sAT + 2 * 64 * 72);
  const int tid = otid(), lane = tid & 63, w = tid >> 6;
  const int d = tid & 127, sq = tid >> 7;
  for (int it = blockIdx.x; it < 528 * 4; it += gridDim.x) {
    const int ch = it >> 2, h = it & 3;
    const int row0 = ch * 64;
    const float lbf = lb_value(P, 0, l, h * 128 + d), lbb = lb_value(P, 1, l, h * 128 + d);
    float gf[16], gb[16], kf[16], kb[16], qs[16];
    u16 vv[16];
    float pf = 0.f, pb = 0.f;
    {
      const u16* src = PA + (size_t)(row0 + sq * 16) * 2560 + h * 128 + d;
#pragma unroll
      for (int j = 0; j < 16; ++j) {
        float q = bf2f(src[(size_t)j * 2560]);
        float zf = bf2f(src[(size_t)j * 2560 + 512]);
        float zb = bf2f(src[(size_t)j * 2560 + 1024]);
        vv[j] = src[(size_t)j * 2560 + 1536];
        qs[j] = siluf(q) * 0.08838834764831845f;
        float sf = sigmf(zf), sb = sigmf(zb);
        float ff = lbf + (1.f - lbf) * sf, fb = lbb + (1.f - lbb) * sb;
        gf[j] = __logf(ff); gb[j] = __logf(fb);
        kf[j] = (1.f - lbf) * (1.f - sf); kb[j] = (1.f - lbb) * (1.f - sb);
        pf += gf[j]; pb += gb[j];
      }
    }
    asm volatile("s_waitcnt vmcnt(0)" ::: "memory");
    __syncthreads();
    ps[(0 * 4 + sq) * 128 + d] = pf;
    ps[(1 * 4 + sq) * 128 + d] = pb;
    __syncthreads();
    float offf = 0.f, totf = 0.f, offb = 0.f, totb = 0.f;
#pragma unroll
    for (int s2 = 0; s2 < 4; ++s2) {
      float a = ps[s2 * 128 + d], b = ps[(4 + s2) * 128 + d];
      totf += a; totb += b;
      if (s2 < sq) offf += a;
      if (s2 > sq) offb += b;
    }
    if (sq == 0) {
      DEC[((size_t)(0 * 528 + ch) * 4 + h) * 128 + d] = __expf(totf);
      DEC[((size_t)(1 * 528 + ch) * 4 + h) * 128 + d] = __expf(totb);
    }
    {
      unsigned kh[8];
      float bc = offf;
#pragma unroll
      for (int j = 0; j < 16; ++j) {
        bc += gf[j];
        const int s = sq * 16 + j;
        u16 qt = f2bf(qs[j] * __expf(bc));
        sQF[s * 136 + d] = qt;
        sKF[s * 136 + d] = f2bf(kf[j] * __expf(fminf(-bc, 80.f)));
        PA[(size_t)(row0 + s) * 2560 + h * 128 + d] = qt;
        u16 khv = f2bf(kf[j] * __expf(totf - bc));
        if (j & 1) kh[j >> 1] |= ((unsigned)khv) << 16; else kh[j >> 1] = khv;
      }
      u16* dst = PA + (size_t)(row0 + (d >> 1)) * 2560 + 512 + h * 128 + (d & 1) * 64 + sq * 16;
      *(uint4*)dst = uint4{kh[0], kh[1], kh[2], kh[3]};
      *(uint4*)(dst + 8) = uint4{kh[4], kh[5], kh[6], kh[7]};
    }
    {
      unsigned kh[8];
      float bc = offb;
#pragma unroll
      for (int j = 15; j >= 0; --j) {
        bc += gb[j];
        const int s = sq * 16 + j;
        u16 qt = f2bf(qs[j] * __expf(bc));
        sQB[s * 136 + d] = qt;
        sKB[s * 136 + d] = f2bf(kb[j] * __expf(fminf(-bc, 80.f)));
        YA[(size_t)(row0 + s) * 512 + h * 128 + d] = qt;
        u16 khv = f2bf(kb[j] * __expf(totb - bc));
        if (j & 1) kh[j >> 1] = ((unsigned)khv) << 16; else kh[j >> 1] |= khv;
      }
      u16* dst = PA + (size_t)(row0 + (d >> 1)) * 2560 + 1024 + h * 128 + (d & 1) * 64 + sq * 16;
      *(uint4*)dst = uint4{kh[0], kh[1], kh[2], kh[3]};
      *(uint4*)(dst + 8) = uint4{kh[4], kh[5], kh[6], kh[7]};
    }
    {
      unsigned vp[8];
#pragma unroll
      for (int j = 0; j < 8; ++j) vp[j] = (unsigned)vv[2 * j] | ((unsigned)vv[2 * j + 1] << 16);
      u16* dst = PA + (size_t)(row0 + (d >> 1)) * 2560 + 1536 + h * 128 + (d & 1) * 64 + sq * 16;
      *(uint4*)dst = uint4{vp[0], vp[1], vp[2], vp[3]};
      *(uint4*)(dst + 8) = uint4{vp[4], vp[5], vp[6], vp[7]};
      u16* ld = sVT + d * 72 + sq * 16;
      *(uint4*)ld = uint4{vp[0], vp[1], vp[2], vp[3]};
      *(uint4*)(ld + 8) = uint4{vp[4], vp[5], vp[6], vp[7]};
    }
    __syncthreads();
    {
      const int dir = w >> 2, tt = w & 3;
      const u16* sQ = dir ? sQB : sQF;
      const u16* sK = dir ? sKB : sKF;
      const int fr = lane & 15, fq = lane >> 4;
      bf16x8 a[4];
#pragma unroll
      for (int ks = 0; ks < 4; ++ks) a[ks] = *(const bf16x8*)(sQ + (tt * 16 + fr) * 136 + ks * 32 + fq * 8);
#pragma unroll
      for (int st = 0; st < 4; ++st) {
        f32x4 c = {0.f, 0.f, 0.f, 0.f};
#pragma unroll
        for (int ks = 0; ks < 4; ++ks) {
          bf16x8 b = *(const bf16x8*)(sK + (st * 16 + fr) * 136 + ks * 32 + fq * 8);
          c = __builtin_amdgcn_mfma_f32_16x16x32_bf16(a[ks], b, c, 0, 0, 0);
        }
        const int s = st * 16 + fr;
#pragma unroll
        for (int i = 0; i < 4; ++i) {
          const int t = tt * 16 + fq * 4 + i;
          bool keep = dir ? (s >= t) : (s <= t);
          sAT[(dir * 64 + t) * 72 + s] = keep ? f2bf(c[i]) : (u16)0;
        }
      }
    }
    __syncthreads();
    {
      const int dir = w >> 2;
      const int fr = lane & 15, fq = lane >> 4;
      u16* OX = dir ? OB : OF;
#pragma unroll
      for (int mi = 0; mi < 2; ++mi) {
        const int mt = (w & 3) * 2 + mi;
        bf16x8 a0 = *(const bf16x8*)(sVT + (mt * 16 + fr) * 72 + fq * 8);
        bf16x8 a1 = *(const bf16x8*)(sVT + (mt * 16 + fr) * 72 + 32 + fq * 8);
#pragma unroll
        for (int nt = 0; nt < 4; ++nt) {
          bf16x8 b0 = *(const bf16x8*)(sAT + (dir * 64 + nt * 16 + fr) * 72 + fq * 8);
          bf16x8 b1 = *(const bf16x8*)(sAT + (dir * 64 + nt * 16 + fr) * 72 + 32 + fq * 8);
          f32x4 c = {0.f, 0.f, 0.f, 0.f};
          c = __builtin_amdgcn_mfma_f32_16x16x32_bf16(a0, b0, c, 0, 0, 0);
          c = __builtin_amdgcn_mfma_f32_16x16x32_bf16(a1, b1, c, 0, 0, 0);
          const int t = nt * 16 + fr, dv = mt * 16 + fq * 4;
          *(uint2*)(OX + (size_t)(row0 + t) * 512 + h * 128 + dv) = uint2{pack2(c[0], c[1]), pack2(c[2], c[3])};
        }
      }
    }
  }
}

struct H2Regs { uint4 qf[4]; uint2 oold; uint4 kt[2]; uint4 vt[2]; float4 dec; };

DI void hgrn_h2(const Params& P, unsigned char* smem) {
  const u16* PA = (const u16*)(P.ws + OFF_BIG);
  const u16* YA = (const u16*)(P.ws + OFF_YA);
  const float* DEC = (const float*)(P.ws + OFF_DEC);
  u16* sS = (u16*)smem;
  const int tid = otid(), lane = tid & 63, w = tid >> 6, fr = lane & 15, fq = lane >> 4;
  for (int it = blockIdx.x; it < 256; it += gridDim.x) {
    const int ds = it & 7, dir = (it >> 3) & 1, h = (it >> 4) & 3, b = it >> 6;
    u16* OX = (u16*)(P.ws + (dir ? OFF_YC : OFF_YB));
    __syncthreads();
    for (int i = tid; i < 16 * 136; i += NTHR) sS[i] = 0;
    f32x4 S = {0.f, 0.f, 0.f, 0.f};
    auto chunk_of = [&](int step) -> int {
      if (step < 4) return 512 + b * 4 + (dir ? 3 - step : step);
      int c = step - 4;
      return b * 128 + (dir ? 127 - c : c);
    };
    auto load = [&](int step, H2Regs& r) {
      const int ch = chunk_of(step), row0 = ch * 64;
      if (w < 4) {
        const int t = w * 16 + fr;
        const u16* qsrc = dir ? (YA + (size_t)(row0 + t) * 512 + h * 128) : (PA + (size_t)(row0 + t) * 2560 + h * 128);
#pragma unroll
        for (int ks = 0; ks < 4; ++ks) r.qf[ks] = *(const uint4*)(qsrc + ks * 32 + fq * 8);
        r.oold = *(const uint2*)(OX + (size_t)(row0 + t) * 512 + h * 128 + ds * 16 + fq * 4);
      }
      const int dd = w * 16 + fr;
      const u16* ksrc = PA + (size_t)(row0 + (dd >> 1)) * 2560 + (dir ? 1024 : 512) + h * 128 + (dd & 1) * 64;
      const int dv = ds * 16 + fr;
      const u16* vsrc = PA + (size_t)(row0 + (dv >> 1)) * 2560 + 1536 + h * 128 + (dv & 1) * 64;
#pragma unroll
      for (int ks = 0; ks < 2; ++ks) {
        r.kt[ks] = *(const uint4*)(ksrc + ks * 32 + fq * 8);
        r.vt[ks] = *(const uint4*)(vsrc + ks * 32 + fq * 8);
      }
      r.dec = *(const float4*)(DEC + ((size_t)(dir * 528 + ch) * 4 + h) * 128 + w * 16 + fq * 4);
    };
    H2Regs cur, nxt;
    load(0, cur);
    __syncthreads();
    for (int step = 0; step < 132; ++step) {
      if (step + 1 < 132) load(step + 1, nxt);
      const int row0 = chunk_of(step) * 64;
      if (w < 4) {
        f32x4 c = {0.f, 0.f, 0.f, 0.f};
#pragma unroll
        for (int ks = 0; ks < 4; ++ks) {
          bf16x8 a = *(const bf16x8*)(sS + fr * 136 + ks * 32 + fq * 8);
          c = __builtin_amdgcn_mfma_f32_16x16x32_bf16(a, __builtin_bit_cast(bf16x8, cur.qf[ks]), c, 0, 0, 0);
        }
        const int t = w * 16 + fr;
        uint2 o;
        o.x = pack2(blo(cur.oold.x) + c[0], bhi(cur.oold.x) + c[1]);
        o.y = pack2(blo(cur.oold.y) + c[2], bhi(cur.oold.y) + c[3]);
        *(uint2*)(OX + (size_t)(row0 + t) * 512 + h * 128 + ds * 16 + fq * 4) = o;
      }
      S[0] *= cur.dec.x; S[1] *= cur.dec.y; S[2] *= cur.dec.z; S[3] *= cur.dec.w;
#pragma unroll
      for (int ks = 0; ks < 2; ++ks)
        S = __builtin_amdgcn_mfma_f32_16x16x32_bf16(__builtin_bit_cast(bf16x8, cur.kt[ks]), __builtin_bit_cast(bf16x8, cur.vt[ks]), S, 0, 0, 0);
      __syncthreads();
      *(uint2*)(sS + fr * 136 + w * 16 + fq * 4) = uint2{pack2(S[0], S[1]), pack2(S[2], S[3])};
      __syncthreads();
      cur = nxt;
    }
  }
}

DI void hgrn_h3(const Params& P, int l, int nrows) {
  const u16* PA = (const u16*)(P.ws + OFF_BIG);
  const u16* OF = (const u16*)(P.ws + OFF_YB);
  const u16* OB = (const u16*)(P.ws + OFF_YC);
  u16* YA = (u16*)(P.ws + OFF_YA);
  const int tid_ = otid(), lane = tid_ & 63, w = tid_ >> 6;
  const float* gain = P.in[12] + l * 128;
  for (int row = blockIdx.x * 8 + w; row < nrows; row += gridDim.x * 8) {
    uint4 a = *(const uint4*)(OF + (size_t)row * 512 + lane * 8);
    uint4 b = *(const uint4*)(OB + (size_t)row * 512 + lane * 8);
    uint4 g = *(const uint4*)(PA + (size_t)row * 2560 + 2048 + lane * 8);
    float o[8] = {blo(a.x) + blo(b.x), bhi(a.x) + bhi(b.x), blo(a.y) + blo(b.y), bhi(a.y) + bhi(b.y),
                  blo(a.z) + blo(b.z), bhi(a.z) + bhi(b.z), blo(a.w) + blo(b.w), bhi(a.w) + bhi(b.w)};
    float gg[8] = {blo(g.x), bhi(g.x), blo(g.y), bhi(g.y), blo(g.z), bhi(g.z), blo(g.w), bhi(g.w)};
    float ss = 0.f;
    for (int j = 0; j < 8; ++j) ss += o[j] * o[j];
    ss = row16_sum(ss);
    float rstd = rsqrtf(ss * (1.f / 128.f) + 1e-6f);
    const int dv0 = (lane & 15) * 8;
    float y[8];
    for (int j = 0; j < 8; ++j) y[j] = o[j] * rstd * gain[dv0 + j] * siluf(gg[j]);
    *(uint4*)(YA + (size_t)row * 512 + lane * 8) = uint4{pack2(y[0], y[1]), pack2(y[2], y[3]), pack2(y[4], y[5]), pack2(y[6], y[7])};
  }
}

DI float2 cmul(float2 a, float2 b) { return float2{a.x * b.x - a.y * b.y, a.x * b.y + a.y * b.x}; }

DI float2 twd(const float2* TQ, int k) {
  const bool lowq = k <= 2048;
  const float2 e = TQ[lowq ? k : 4096 - k];
  return lowq ? float2{e.x, -e.y} : float2{e.y, -e.x};
}

DI int ph(int i) { return i + (i >> 7); }

DI void bfly_fwd(float2& a0, float2& a1, float2& a2, float2& a3, float2 w1) {
  float2 w2 = cmul(w1, w1);
  float2 b0 = {a0.x + a2.x, a0.y + a2.y};
  float2 b2 = cmul(float2{a0.x - a2.x, a0.y - a2.y}, w1);
  float2 b1 = {a1.x + a3.x, a1.y + a3.y};
  float2 d3 = {a1.x - a3.x, a1.y - a3.y};
  float2 b3 = cmul(float2{d3.y, -d3.x}, w1);
  a0 = float2{b0.x + b1.x, b0.y + b1.y};
  a1 = cmul(float2{b0.x - b1.x, b0.y - b1.y}, w2);
  a2 = float2{b2.x + b3.x, b2.y + b3.y};
  a3 = cmul(float2{b2.x - b3.x, b2.y - b3.y}, w2);
}
DI void bfly_inv(float2& a0, float2& a1, float2& a2, float2& a3, float2 w1) {
  float2 w2 = cmul(w1, w1);
  float2 t = cmul(a1, w2);
  float2 b0 = {a0.x + t.x, a0.y + t.y}, b1 = {a0.x - t.x, a0.y - t.y};
  t = cmul(a3, w2);
  float2 b2 = {a2.x + t.x, a2.y + t.y}, b3 = {a2.x - t.x, a2.y - t.y};
  t = cmul(b2, w1);
  a0 = float2{b0.x + t.x, b0.y + t.y};
  a2 = float2{b0.x - t.x, b0.y - t.y};
  float2 u = cmul(b3, w1);
  t = float2{-u.y, u.x};
  a1 = float2{b1.x + t.x, b1.y + t.y};
  a3 = float2{b1.x - t.x, b1.y - t.y};
}

template <bool INV, int LH>
DI void fft_pass(float2* X, const float2* __restrict__ TW, int tid) {
  constexpr int h = 1 << LH, hh = h >> 1;
  asm volatile("" : "+v"(tid));
  int p0[8], lo[8];
  float2 a0[8], a1[8], a2[8], a3[8], w1[8];
#pragma unroll
  for (int k = 0; k < 8; ++k) {
    const int q = tid + k * NTHR;
    if (LH >= 7) {
      lo[k] = q & (hh - 1);
      const int hi = q >> (LH - 1);
      p0[k] = (hi << (LH + 1)) + lo[k];
    } else {
      const int r = q & 127, bidx = q >> 7;
      lo[k] = bidx & (hh - 1);
      const int hi = bidx >> (LH - 1);
      p0[k] = r * 129 + (hi << (LH + 1)) + lo[k];
    }
    w1[k] = twd(TW, lo[k] << (13 - LH));
  }
#pragma unroll
  for (int k = 0; k < 8; ++k) {
    if (LH >= 7) {
      const int i0 = p0[k];
      a0[k] = X[ph(i0)]; a1[k] = X[ph(i0 + hh)]; a2[k] = X[ph(i0 + h)]; a3[k] = X[ph(i0 + h + hh)];
    } else {
      a0[k] = X[p0[k]]; a1[k] = X[p0[k] + hh]; a2[k] = X[p0[k] + h]; a3[k] = X[p0[k] + h + hh];
    }
  }
#pragma unroll
  for (int k = 0; k < 8; ++k) {
    float2 w = w1[k];
    if (INV) { w.y = -w.y; bfly_inv(a0[k], a1[k], a2[k], a3[k], w); }
    else bfly_fwd(a0[k], a1[k], a2[k], a3[k], w);
    if (LH >= 7) {
      const int i0 = p0[k];
      X[ph(i0)] = a0[k]; X[ph(i0 + hh)] = a1[k]; X[ph(i0 + h)] = a2[k]; X[ph(i0 + h + hh)] = a3[k];
    } else {
      X[p0[k]] = a0[k]; X[p0[k] + hh] = a1[k]; X[p0[k] + h] = a2[k]; X[p0[k] + h + hh] = a3[k];
    }
  }
  __syncthreads();
}

DI void fft_fwd(float2* X, const float2* __restrict__ TW) {
  const int tid = otid();
  fft_pass<false, 13>(X, TW, tid); fft_pass<false, 11>(X, TW, tid); fft_pass<false, 9>(X, TW, tid); fft_pass<false, 7>(X, TW, tid);
  fft_pass<false, 5>(X, TW, tid); fft_pass<false, 3>(X, TW, tid); fft_pass<false, 1>(X, TW, tid);
}
DI void fft_inv(float2* X, const float2* __restrict__ TW) {
  const int tid = otid();
  fft_pass<true, 1>(X, TW, tid); fft_pass<true, 3>(X, TW, tid); fft_pass<true, 5>(X, TW, tid); fft_pass<true, 7>(X, TW, tid);
  fft_pass<true, 9>(X, TW, tid); fft_pass<true, 11>(X, TW, tid); fft_pass<true, 13>(X, TW, tid);
}

DI float hy_delta(int c) {
  const float mn = -3.0701134573253945f, mx = -15.350567286626973f;
  return fabsf(mn + (mx - mn) * ((float)c / 511.f));
}

DI float conv3_at(const u16* seq, int t, int L, float w0, float w1, float w2, float bias) {
  float c = bf2f(seq[t]);
  float a = t > 0 ? bf2f(seq[t - 1]) : 0.f;
  float b = t < L - 1 ? bf2f(seq[t + 1]) : 0.f;
  return a * w0 + c * w1 + b * w2 + bias;
}

DI void hyena_phase(const Params& P, int l, unsigned char* smem) {
  float2* X = (float2*)smem;
  float* ex = (float*)(smem + 132096);
  const u16* PB = (const u16*)(P.ws + OFF_BIG);
  u16* YB = (u16*)(P.ws + OFF_YB);
  const u16* HID = (const u16*)(P.ws + OFF_HID3);
  const float2* TWG = (const float2*)(P.ws + OFF_TW);
  float2* TWL = (float2*)(smem + 134144);
  const float2* TW = TWL;
  float2* FS = (float2*)(P.ws + OFF_BIG + BIG_FSCR) + (size_t)blockIdx.x * 40960;
  const float* w4 = P.in[21] + (size_t)l * 64 * 2048;
  const float* cw = P.in[13] + l * 3 * 1536;
  const float* cb = P.in[14] + l * 1536;
  const int tid = otid();
  __syncthreads();
  for (int k = tid; k <= 2048; k += NTHR) { float2 e = TWG[k]; TWL[k] = float2{e.x, -e.y}; }
  __syncthreads();
  for (int it = blockIdx.x; it < 512; it += gridDim.x) {
    const int xcd = it & 7, j = (it >> 3) & 31, grp = (it >> 8) * 8 + xcd;
    const int c = grp * 32 + j;
    __syncthreads();
    if (tid < 256) { int f = tid & 63, wh = tid >> 6; ex[tid] = w4[f * 2048 + (wh >> 1) * 1024 + (wh & 1) * 512 + c]; }
    __syncthreads();
    const float delta = hy_delta(c);
    float n0 = 0.f, n1 = 0.f;
    {
      const int lane = tid & 63, wv = tid >> 6, fr = lane & 15, fq = lane >> 4;
      bf16x8 wa0, wa1;
      {
        unsigned t0[4], t1[4];
#pragma unroll
        for (int j = 0; j < 4; ++j) {
          const float a0 = fr < 4 ? ex[fr * 64 + fq * 8 + 2 * j] : 0.f, a1 = fr < 4 ? ex[fr * 64 + fq * 8 + 2 * j + 1] : 0.f;
          const float c0 = fr < 4 ? ex[fr * 64 + 32 + fq * 8 + 2 * j] : 0.f, c1 = fr < 4 ? ex[fr * 64 + 32 + fq * 8 + 2 * j + 1] : 0.f;
          t0[j] = pack2(a0, a1); t1[j] = pack2(c0, c1);
        }
        wa0 = __builtin_bit_cast(bf16x8, uint4{t0[0], t0[1], t0[2], t0[3]});
        wa1 = __builtin_bit_cast(bf16x8, uint4{t1[0], t1[1], t1[2], t1[3]});
      }
#pragma unroll 4
      for (int g = wv; g < 1024; g += 8) {
        const int n = g * 16 + fr;
        const int dir = n > 8192 ? 1 : 0;
        const int pos = dir ? 16384 - n : n;
        const uint4* hp = (const uint4*)(HID + (size_t)pos * 64 + fq * 8);
        const bf16x8 b0 = __builtin_bit_cast(bf16x8, hp[0]);
        const bf16x8 b1 = __builtin_bit_cast(bf16x8, hp[4]);
        f32x4 d = {0.f, 0.f, 0.f, 0.f};
        d = __builtin_amdgcn_mfma_f32_16x16x32_bf16(wa0, b0, d, 0, 0, 0);
        d = __builtin_amdgcn_mfma_f32_16x16x32_bf16(wa1, b1, d, 0, 0, 0);
        if (fq == 0) {
          float k0 = dir ? d[2] : d[0], k1 = dir ? d[3] : d[1];
          const float win = __expf(-((float)pos / 8191.f) * delta) + 0.05f;
          k0 *= win; k1 *= win;
          if (n == 8192) { k0 = 0.f; k1 = 0.f; }
          n0 += fabsf(k0); n1 += fabsf(k1);
          X[ph(n)] = float2{k0, k1};
        }
      }
    }
    const float norm0 = block_sum(n0, ex + 256), norm1 = block_sum(n1, ex + 272);
    __syncthreads();
    fft_fwd(X, TW);
    {
      const float s0 = 1.f / (norm0 * 16384.f), s1 = 1.f / (norm1 * 16384.f);
#pragma unroll 4
      for (int p = tid; p < 16384; p += NTHR) {
        const int f = (int)(__brev((unsigned)p) >> 18);
        const int p2 = (int)(__brev((unsigned)((16384 - f) & 16383)) >> 18);
        float2 a = X[ph(p)], b = X[ph(p2)];
        FS[p] = float2{(a.x + b.x) * 0.5f * s0, (a.y - b.y) * 0.5f * s0};
        FS[16384 + p] = float2{(a.y + b.y) * 0.5f * s1, -(a.x - b.x) * 0.5f * s1};
      }
    }
    const float cwz0 = cw[1024 + c], cwz1 = cw[1536 + 1024 + c], cwz2 = cw[3072 + 1024 + c], cbz = cb[1024 + c];
    float2* VS = FS + 32768;
    for (int bp = 0; bp < 2; ++bp) {
      const int rb0 = (2 * bp) * 8192, rb1 = rb0 + 8192;
      const u16* z0 = PB + ((size_t)((2 * bp) * 1536 + 1024 + c) << 13);
      const u16* z1 = PB + ((size_t)((2 * bp + 1) * 1536 + 1024 + c) << 13);
#pragma unroll 1
      for (int o = 0; o < 2; ++o) {
        int tl = tid; asm volatile("" : "+v"(tl));
        __syncthreads();
#pragma unroll
        for (int kb = 0; kb < 8; kb += 4) {
          asm volatile("" : "+v"(tl));
          float2 a0[4], a1[4], w1[4];
#pragma unroll
          for (int k = 0; k < 4; ++k) {
            const int q = tl + (kb + k) * NTHR;
            if (o == 0) {
              a0[k].x = conv3_at(z0, q, 8192, cwz0, cwz1, cwz2, cbz);
              a0[k].y = conv3_at(z1, q, 8192, cwz0, cwz1, cwz2, cbz);
              a1[k].x = conv3_at(z0, q + 4096, 8192, cwz0, cwz1, cwz2, cbz);
              a1[k].y = conv3_at(z1, q + 4096, 8192, cwz0, cwz1, cwz2, cbz);
              VS[q] = a0[k]; VS[q + 4096] = a1[k];
            } else { a0[k] = VS[q]; a1[k] = VS[q + 4096]; }
            w1[k] = twd(TW, q);
          }
#pragma unroll
          for (int k = 0; k < 4; ++k) {
            const int q = tl + (kb + k) * NTHR;
            float2 a2 = {0.f, 0.f}, a3 = {0.f, 0.f};
            bfly_fwd(a0[k], a1[k], a2, a3, w1[k]);
            X[ph(q)] = a0[k]; X[ph(q + 4096)] = a1[k]; X[ph(q + 8192)] = a2; X[ph(q + 12288)] = a3;
          }
        }
        __syncthreads();
        fft_pass<false, 11>(X, TW, tl); fft_pass<false, 9>(X, TW, tl); fft_pass<false, 7>(X, TW, tl);
        fft_pass<false, 5>(X, TW, tl); fft_pass<false, 3>(X, TW, tl);
        {
          const float2* Ks = FS + o * 16384;
#pragma unroll
          for (int kb = 0; kb < 8; kb += 4) {
            asm volatile("" : "+v"(tl));
            float2 e0[4], e1[4], e2[4], e3[4];
            float4 kA[4], kB[4];
#pragma unroll
            for (int k = 0; k < 4; ++k) {
              const int q = tl + (kb + k) * NTHR;
              const int r = q & 127, bidx = q >> 7;
              const int p0 = r * 129 + bidx * 4;
              e0[k] = X[p0]; e1[k] = X[p0 + 1]; e2[k] = X[p0 + 2]; e3[k] = X[p0 + 3];
              const float4* kp = (const float4*)(Ks + r * 128 + bidx * 4);
              kA[k] = kp[0]; kB[k] = kp[1];
            }
#pragma unroll
            for (int k = 0; k < 4; ++k) {
              const int q = tl + (kb + k) * NTHR;
              const int r = q & 127, bidx = q >> 7;
              const int p0 = r * 129 + bidx * 4;
              const float2 one = {1.f, 0.f};
              bfly_fwd(e0[k], e1[k], e2[k], e3[k], one);
              e0[k] = cmul(e0[k], float2{kA[k].x, kA[k].y}); e1[k] = cmul(e1[k], float2{kA[k].z, kA[k].w});
              e2[k] = cmul(e2[k], float2{kB[k].x, kB[k].y}); e3[k] = cmul(e3[k], float2{kB[k].z, kB[k].w});
              bfly_inv(e0[k], e1[k], e2[k], e3[k], one);
              X[p0] = e0[k]; X[p0 + 1] = e1[k]; X[p0 + 2] = e2[k]; X[p0 + 3] = e3[k];
            }
          }
          __syncthreads();
        }
        fft_pass<true, 3>(X, TW, tl); fft_pass<true, 5>(X, TW, tl); fft_pass<true, 7>(X, TW, tl);
        fft_pass<true, 9>(X, TW, tl); fft_pass<true, 11>(X, TW, tl);
        const int gc = o * 512 + c;
        const float g0 = cw[gc], g1 = cw[1536 + gc], g2 = cw[3072 + gc], gbias = cb[gc];
        const float skip = P.in[23][(l * 2 + o) * 512 + c];
        const u16* x0p = PB + ((size_t)((2 * bp) * 1536 + gc) << 13);
        const u16* x1p = PB + ((size_t)((2 * bp + 1) * 1536 + gc) << 13);
#pragma unroll
        for (int kb = 0; kb < 8; kb += 4) {
          asm volatile("" : "+v"(tl));
          float2 a0[4], a1[4], a2[4], a3[4], w1[4], vo0[4], vo1[4];
          float xa[4], xb[4], xc2[4], xd[4];
#pragma unroll
          for (int k = 0; k < 4; ++k) {
            const int q = tl + (kb + k) * NTHR;
            a0[k] = X[ph(q)]; a1[k] = X[ph(q + 4096)]; a2[k] = X[ph(q + 8192)]; a3[k] = X[ph(q + 12288)];
            w1[k] = twd(TW, q); w1[k].y = -w1[k].y;
            vo0[k] = VS[q]; vo1[k] = VS[q + 4096];
            xa[k] = conv3_at(x0p, q, 8192, g0, g1, g2, gbias);
            xb[k] = conv3_at(x1p, q, 8192, g0, g1, g2, gbias);
            xc2[k] = conv3_at(x0p, q + 4096, 8192, g0, g1, g2, gbias);
            xd[k] = conv3_at(x1p, q + 4096, 8192, g0, g1, g2, gbias);
          }
#pragma unroll
          for (int k = 0; k < 4; ++k) {
            const int q = tl + (kb + k) * NTHR;
            bfly_inv(a0[k], a1[k], a2[k], a3[k], w1[k]);
            float2 n0v, n1v;
            n0v.x = xa[k] * (a0[k].x + vo0[k].x * skip);
            n0v.y = xb[k] * (a0[k].y + vo0[k].y * skip);
            n1v.x = xc2[k] * (a1[k].x + vo1[k].x * skip);
            n1v.y = xd[k] * (a1[k].y + vo1[k].y * skip);
            if (o == 0) { VS[q] = n0v; VS[q + 4096] = n1v; }
            else {
              YB[(size_t)(rb0 + q) * 512 + c] = f2bf(n0v.x);
              YB[(size_t)(rb1 + q) * 512 + c] = f2bf(n0v.y);
              YB[(size_t)(rb0 + q + 4096) * 512 + c] = f2bf(n1v.x);
              YB[(size_t)(rb1 + q + 4096) * 512 + c] = f2bf(n1v.y);
            }
          }
        }
      }
    }
  }
}

DI void hyena_ctx_phase(const Params& P, int l, unsigned char* smem) {
  float* kf = (float*)smem;
  float* vz = kf + 1024;
  float* red = vz + 1024;
  const u16* PBC = (const u16*)(P.ws + OFF_BIG) + (size_t)4 * 1536 * 8192;
  u16* YB = (u16*)(P.ws + OFF_YB);
  const u16* HID = (const u16*)(P.ws + OFF_HID3) + (size_t)8192 * 64;
  const float* w4 = P.in[21] + (size_t)l * 64 * 2048;
  const float* cw = P.in[13] + l * 3 * 1536;
  const float* cb = P.in[14] + l * 1536;
  const int tid = otid();
  for (int c = blockIdx.x; c < 512; c += gridDim.x) {
    const float delta = hy_delta(c);
    __syncthreads();
    float n0 = 0.f, n1 = 0.f;
    for (int idx = tid; idx < 1024; idx += NTHR) {
      const int pos = idx & 255, wh = idx >> 8, dir = wh >> 1, o = wh & 1;
      float a = 0.f;
      for (int f = 0; f < 64; ++f) a += bf2f(HID[pos * 64 + f]) * w4[f * 2048 + dir * 1024 + o * 512 + c];
      a *= __expf(-((float)pos / 255.f) * delta) + 0.05f;
      kf[idx] = a;
      if (!(dir == 1 && pos == 0)) { if (o == 0) n0 += fabsf(a); else n1 += fabsf(a); }
    }
    const float norm0 = block_sum(n0, red), norm1 = block_sum(n1, red + 16);
    float vreg[2];
    for (int r = 0; r < 2; ++r) {
      const int idx = tid + r * 512, b = idx >> 8, t = idx & 255;
      vreg[r] = conv3_at(PBC + ((size_t)(b * 1536 + 1024 + c) << 8), t, 256, cw[1024 + c], cw[1536 + 1024 + c], cw[3072 + 1024 + c], cb[1024 + c]);
    }
    for (int o = 0; o < 2; ++o) {
      __syncthreads();
      for (int r = 0; r < 2; ++r) vz[tid + r * 512] = vreg[r];
      __syncthreads();
      const float inv = 1.f / (o == 0 ? norm0 : norm1);
      const int gc = o * 512 + c;
      const float skip = P.in[23][(l * 2 + o) * 512 + c];
      for (int r = 0; r < 2; ++r) {
        const int idx = tid + r * 512, b = idx >> 8, t = idx & 255;
        float y = 0.f;
        for (int s = 0; s < 256; ++s) {
          const int lag = t - s;
          float kk = lag >= 0 ? kf[(0 * 2 + o) * 256 + lag] : kf[(1 * 2 + o) * 256 - lag];
          y += kk * vz[b * 256 + s];
        }
        y *= inv;
        float xg = conv3_at(PBC + ((size_t)(b * 1536 + gc) << 8), t, 256, cw[gc], cw[1536 + gc], cw[3072 + gc], cb[gc]);
        vreg[r] = xg * (y + vreg[r] * skip);
      }
    }
    for (int r = 0; r < 2; ++r) {
      const int idx = tid + r * 512, b = idx >> 8, t = idx & 255;
      YB[(size_t)(RL + b * 256 + t) * 512 + c] = f2bf(vreg[r]);
    }
  }
}

DI float rope_inv(int i) { return exp2f(-(float)(2 * i) * (13.287712379549449f / 32.f)); }

DI float axial_rope_lane(float x, int lane, int t) {
  const int sec = lane >> 5, jj = lane & 31, i = jj & 15;
  const float posc = sec ? (float)(t & 63) : (float)(t >> 6);
  float sn, cs;
  sincosf(posc * rope_inv(i), &sn, &cs);
  float partner = shx(x, 16, lane);
  return (jj < 16) ? (x * cs - partner * sn) : (x * cs + partner * sn);
}

DI void mla_e1(const Params& P, int l) {
  u16* PC = (u16*)(P.ws + OFF_BIG);
  const int tid_ = otid(), lane = tid_ & 63, w = tid_ >> 6;
  const float* qan = P.in[24] + l * 256; const float* kvn = P.in[26] + l * 128; const float* krn = P.in[31] + l * 64;
  for (int row = blockIdx.x * 8 + w; row < RA; row += gridDim.x * 8) {
    u16* pr = PC + (size_t)row * 448;
    uint2 qa = *(const uint2*)(pr + lane * 4);
    unsigned kv = *(const unsigned*)(pr + 256 + lane * 2);
    float kr = bf2f(pr[384 + lane]);
    float q0 = blo(qa.x), q1 = bhi(qa.x), q2 = blo(qa.y), q3 = bhi(qa.y);
    float ssq = wave_sum(q0 * q0 + q1 * q1 + q2 * q2 + q3 * q3, lane);
    float rq = rsqrtf(ssq * (1.f / 256.f) + 1e-6f);
    float k0 = blo(kv), k1 = bhi(kv);
    float ssk = wave_sum(k0 * k0 + k1 * k1, lane);
    float rk = rsqrtf(ssk * (1.f / 128.f) + 1e-6f);
    float ssr = wave_sum(kr * kr, lane);
    float rr = rsqrtf(ssr * (1.f / 64.f) + 1e-6f);
    *(uint2*)(pr + lane * 4) = uint2{pack2(q0 * rq * qan[lane * 4], q1 * rq * qan[lane * 4 + 1]), pack2(q2 * rq * qan[lane * 4 + 2], q3 * rq * qan[lane * 4 + 3])};
    *(unsigned*)(pr + 256 + lane * 2) = pack2(k0 * rk * kvn[lane * 2], k1 * rk * kvn[lane * 2 + 1]);
    float x = kr * rr * krn[lane];
    if (row < RL) x = axial_rope_lane(x, lane, row & 8191);
    pr[384 + lane] = f2bf(x);
  }
}

DI void mla_e2(const Params& P, int l) {
  const u16* PC = (const u16*)(P.ws + OFF_BIG);
  u16* Q = (u16*)(P.ws + OFF_BIG + BIG_Q);
  u16* K = (u16*)(P.ws + OFF_BIG + BIG_K);
  const int tid_ = otid(), lane = tid_ & 63, w = tid_ >> 6;
  const float* qnn = P.in[28] + l * 128; const float* qrn = P.in[29] + l * 64; const float* knn = P.in[30] + l * 128;
  const float qscale = 0.07216878364870322f * 1.4426950408889634f;
  for (int row = blockIdx.x * 8 + w; row < RA; row += gridDim.x * 8) {
    u16 krr = PC[(size_t)row * 448 + 384 + lane];
    for (int h = 0; h < 4; ++h) {
      u16* qp = Q + (size_t)row * 768 + h * 192;
      unsigned qn = *(const unsigned*)(qp + lane * 2);
      float qr = bf2f(qp[128 + lane]);
      float a0 = blo(qn), a1 = bhi(qn);
      float r1 = rsqrtf(wave_sum(a0 * a0 + a1 * a1, lane) * (1.f / 128.f) + 1e-6f);
      float r2 = rsqrtf(wave_sum(qr * qr, lane) * (1.f / 64.f) + 1e-6f);
      *(unsigned*)(qp + lane * 2) = pack2(a0 * r1 * qnn[lane * 2] * qscale, a1 * r1 * qnn[lane * 2 + 1] * qscale);
      float x = qr * r2 * qrn[lane];
      if (row < RL) x = axial_rope_lane(x, lane, row & 8191);
      qp[128 + lane] = f2bf(x * qscale);
      u16* kp = K + (size_t)row * 768 + h * 192;
      unsigned kn = *(const unsigned*)(kp + lane * 2);
      float b0 = blo(kn), b1 = bhi(kn);
      float r3 = rsqrtf(wave_sum(b0 * b0 + b1 * b1, lane) * (1.f / 128.f) + 1e-6f);
      *(unsigned*)(kp + lane * 2) = pack2(b0 * r3 * knn[lane * 2], b1 * r3 * knn[lane * 2 + 1]);
      kp[128 + lane] = krr;
    }
  }
}

DI void attn_phase(const Params& P, bool with_ctx_queries, unsigned char* smem) {
  const u16* Q = (const u16*)(P.ws + OFF_BIG + BIG_Q);
  const u16* K = (const u16*)(P.ws + OFF_BIG + BIG_K);
  const u16* VT = (const u16*)(P.ws + OFF_BIG + BIG_VT);
  u16* YC = (u16*)(P.ws + OFF_YC);
  const int tid = otid(), lane = tid & 63, w = tid >> 6, ql = lane & 31, half = lane >> 5;
  const int nitems = 512 + (with_ctx_queries ? 16 : 0);
  for (int it = blockIdx.x; it < nitems; it += gridDim.x) {
    int b, h, qrow0, kt0;
    if (it < 512) { b = it >> 7; h = (it >> 5) & 3; qrow0 = b * 8192 + (it & 31) * 256; kt0 = 0; }
    else { int i2 = it - 512; b = i2 >> 2; h = i2 & 3; qrow0 = RL + b * 256; kt0 = 128; }
    const int qrow = qrow0 + w * 32 + ql;
    bf16x8 qf[12];
    {
      const u16* qp = Q + (size_t)qrow * 768 + h * 192 + half * 8;
#pragma unroll
      for (int ks = 0; ks < 12; ++ks) qf[ks] = *(const bf16x8*)(qp + ks * 16);
    }
    f32x16 O[4];
#pragma unroll
    for (int dt = 0; dt < 4; ++dt)
#pragma unroll
      for (int i = 0; i < 16; ++i) O[dt][i] = 0.f;
    float m_run = -1e30f, l_run = 0.f;
    uint4 pre0, pre1, pre2, pre3, pre4;
#define ATT_GLOAD(KT) do { const int kt_ = (KT); \
      const int krow0 = kt_ < 128 ? b * 8192 + kt_ * 64 : RL + b * 256 + (kt_ - 128) * 64; \
      const u16* kp_ = K + (size_t)(krow0 + (tid >> 3)) * 768 + h * 192 + (tid & 7) * 8; \
      pre0 = *(const uint4*)(kp_); pre1 = *(const uint4*)(kp_ + 64); pre2 = *(const uint4*)(kp_ + 128); \
      const u16* vb_ = VT + ((size_t)(b * 132 + kt_) * 4 + h) * 8192 + tid * 16; \
      pre3 = *(const uint4*)(vb_); pre4 = *(const uint4*)(vb_ + 8); } while (0)
#define ATT_SSTORE(BUF) do { unsigned char* kb_ = smem + (BUF) * 43008 + (tid >> 3) * 400 + (tid & 7) * 16; \
      *(uint4*)(kb_) = pre0; *(uint4*)(kb_ + 128) = pre1; *(uint4*)(kb_ + 256) = pre2; \
      unsigned char* vb2_ = smem + (BUF) * 43008 + 25600 + (tid >> 2) * 136 + (tid & 3) * 32; \
      *(uint4*)(vb2_) = pre3; *(uint4*)(vb2_ + 16) = pre4; } while (0)
    __syncthreads();
    ATT_GLOAD(kt0); ATT_SSTORE(0);
    __syncthreads();
    for (int kt = kt0; kt < 132; ++kt) {
      const bool more = kt + 1 < 132;
      if (more) ATT_GLOAD(kt + 1);
      const unsigned char* kb = smem + ((kt - kt0) & 1) * 43008;
      const unsigned char* vb = kb + 25600;
      f32x16 S[2];
#pragma unroll
      for (int mt = 0; mt < 2; ++mt)
#pragma unroll
        for (int i = 0; i < 16; ++i) S[mt][i] = 0.f;
#define KFRAG(KS, MT) (*(const bf16x8*)(kb + ((MT) * 32 + ql) * 400 + ((KS) * 16 + half * 8) * 2))
      bf16x8 ka0 = KFRAG(0, 0), ka1 = KFRAG(0, 1), kc0, kc1;
      __builtin_amdgcn_sched_barrier(0);
#pragma unroll
      for (int ks = 0; ks < 12; ks += 2) {
        kc0 = KFRAG(ks + 1, 0); kc1 = KFRAG(ks + 1, 1);
        __builtin_amdgcn_sched_barrier(0);
        S[0] = __builtin_amdgcn_mfma_f32_32x32x16_bf16(ka0, qf[ks], S[0], 0, 0, 0);
        S[1] = __builtin_amdgcn_mfma_f32_32x32x16_bf16(ka1, qf[ks], S[1], 0, 0, 0);
        __builtin_amdgcn_sched_barrier(0);
        if (ks + 2 < 12) { ka0 = KFRAG(ks + 2, 0); ka1 = KFRAG(ks + 2, 1); }
        __builtin_amdgcn_sched_barrier(0);
        S[0] = __builtin_amdgcn_mfma_f32_32x32x16_bf16(kc0, qf[ks + 1], S[0], 0, 0, 0);
        S[1] = __builtin_amdgcn_mfma_f32_32x32x16_bf16(kc1, qf[ks + 1], S[1], 0, 0, 0);
        __builtin_amdgcn_sched_barrier(0);
      }
#undef KFRAG
      float mx = S[0][0];
#pragma unroll
      for (int i = 1; i < 16; ++i) mx = fmaxf(mx, S[0][i]);
#pragma unroll
      for (int i = 0; i < 16; ++i) mx = fmaxf(mx, S[1][i]);
      mx = fmaxf(mx, shx(mx, 32, lane));
      const float m_new = fmaxf(m_run, mx);
      const float alpha = __builtin_amdgcn_exp2f(m_run - m_new);
      m_run = m_new;
      float ps = 0.f;
#pragma unroll
      for (int mt = 0; mt < 2; ++mt)
#pragma unroll
        for (int i = 0; i < 16; ++i) { float p = __builtin_amdgcn_exp2f(S[mt][i] - m_new); S[mt][i] = p; ps += p; }
      l_run = l_run * alpha + ps;
      if (__builtin_amdgcn_ballot_w64(alpha != 1.f) != 0) {
#pragma unroll
        for (int dt = 0; dt < 4; ++dt)
#pragma unroll
          for (int i = 0; i < 16; ++i) O[dt][i] *= alpha;
      }
#pragma unroll
      for (int mt = 0; mt < 2; ++mt) {
#pragma unroll
        for (int sp = 0; sp < 2; ++sp) {
          uint4 pk;
          pk.x = pack2(S[mt][8 * sp + 0], S[mt][8 * sp + 1]);
          pk.y = pack2(S[mt][8 * sp + 2], S[mt][8 * sp + 3]);
          pk.z = pack2(S[mt][8 * sp + 4], S[mt][8 * sp + 5]);
          pk.w = pack2(S[mt][8 * sp + 6], S[mt][8 * sp + 7]);
          const bf16x8 pb = __builtin_bit_cast(bf16x8, pk);
          const int k1 = mt * 32 + 16 * sp + 4 * half;
#pragma unroll
          for (int dt = 0; dt < 4; ++dt) {
            const unsigned char* vp = vb + (dt * 32 + ql) * 136 + k1 * 2;
            uint2 lo = *(const uint2*)vp;
            uint2 hi = *(const uint2*)(vp + 16);
            const bf16x8 a = __builtin_bit_cast(bf16x8, uint4{lo.x, lo.y, hi.x, hi.y});
            O[dt] = __builtin_amdgcn_mfma_f32_32x32x16_bf16(a, pb, O[dt], 0, 0, 0);
          }
        }
      }
      if (more) ATT_SSTORE((kt + 1 - kt0) & 1);
      __syncthreads();
    }
    const float lt = l_run + shx(l_run, 32, lane);
    const float inv = 1.f / lt;
    u16* yp = YC + (size_t)qrow * 512 + h * 128;
#pragma unroll
    for (int dt = 0; dt < 4; ++dt)
#pragma unroll
      for (int g = 0; g < 4; ++g) {
        const int dv = dt * 32 + 8 * g + 4 * half;
        *(uint2*)(yp + dv) = uint2{pack2(O[dt][4 * g] * inv, O[dt][4 * g + 1] * inv), pack2(O[dt][4 * g + 2] * inv, O[dt][4 * g + 3] * inv)};
      }
  }
}

DI void ffn_phases(const Params& P, GBar& grid, int l, int f, int nr, unsigned char* smem) {
  u16* WB = (u16*)(P.ws + OFF_WB);
  u16* HB = (u16*)(P.ws + OFF_HB);
  u16* BIG = (u16*)(P.ws + OFF_BIG);
  const u16* W13 = WB + (f == 0 ? W_13A : W_13B);
  const u16* W2 = WB + (f == 0 ? W_2A : W_2B);
  const int gidx = f == 0 ? 2 : 8;
  gemm_phase2(HB, 1024, W13, 1024, 1024, nr, 5632, smem, [&](f32x4 (&acc)[8][4], int rbase, int cbase) {
#pragma unroll
    for (int ct = 0; ct < 8; ct += 2)
#pragma unroll
      for (int tt = 0; tt < 4; ++tt) {
        const int row = rbase + tt * 16;
        const int fq4 = cbase & 12;
        const int j = ((cbase - fq4 + ct * 16) >> 1) + fq4;
        f32x4 a = acc[ct][tt], b = acc[ct + 1][tt];
        *(uint2*)(BIG + (size_t)row * 2816 + j) = uint2{pack2(siluf(a[0]) * b[0], siluf(a[1]) * b[1]), pack2(siluf(a[2]) * b[2], siluf(a[3]) * b[3])};
      }
  });
  grid.sync();
  gemm_phase(BIG, 2816, W2, 2816, 2816, nr, 1024, smem, [&](f32x4 (&acc)[4][4], int rbase, int cbase) {
    float4 g[4];
    const float* mdp = modp(P, l, rbase) + gidx * 1024 + cbase;
#pragma unroll
    for (int ct = 0; ct < 4; ++ct) g[ct] = *(const float4*)(mdp + ct * 16);
#pragma unroll
    for (int tt = 0; tt < 4; ++tt) {
      float4* xp = (float4*)(xrow(P, rbase + tt * 16) + cbase);
      float4 xv[4];
#pragma unroll
      for (int ct = 0; ct < 4; ++ct) xv[ct] = xp[ct * 4];
      __builtin_amdgcn_sched_barrier(0);
#pragma unroll
      for (int ct = 0; ct < 4; ++ct) {
        xv[ct].x += 0.5f * g[ct].x * acc[ct][tt][0]; xv[ct].y += 0.5f * g[ct].y * acc[ct][tt][1];
        xv[ct].z += 0.5f * g[ct].z * acc[ct][tt][2]; xv[ct].w += 0.5f * g[ct].w * acc[ct][tt][3];
      }
#pragma unroll
      for (int ct = 0; ct < 4; ++ct) xp[ct * 4] = xv[ct];
    }
  });
  grid.sync();
}


__global__ void __launch_bounds__(NTHR) fwd_megakernel(Params P) {
  extern __shared__ __attribute__((aligned(16))) unsigned char smem[];
  cg::grid_group cgrid = cg::this_grid();
  GBar grid; grid.bar = (unsigned*)(P.ws + OFF_BAR); grid.post();
  u16* WB = (u16*)(P.ws + OFF_WB);
  u16* HB = (u16*)(P.ws + OFF_HB);
  u16* BIG = (u16*)(P.ws + OFF_BIG);
  u16* YA = (u16*)(P.ws + OFF_YA);
  u16* YB = (u16*)(P.ws + OFF_YB);
  u16* YC = (u16*)(P.ws + OFF_YC);

  mods_phase(P, smem);
  convert_phase(P, 0, smem);
  hid3_phase(P, 0, smem);
  cgrid.sync();
  grid.census();

  for (int l = 0; l < 2; ++l) {
    const int nrows2 = (l == 0) ? RA : RL;
    norm_phase(P, l, 0, RA, l == 0);
    if (l == 1) { convert_phase(P, 1, smem); hid3_phase(P, 1, smem); }
    grid.sync();
    ffn_phases(P, grid, l, 0, RA, smem);
    {

      norm_phase(P, l, 1, RA, false);
      grid.sync();
      gemm_phase2(HB, 1024, WB + W_IN, 1024, 1024, RA, 2560, smem, [&](f32x4 (&acc)[8][4], int rbase, int cbase) {
#pragma unroll
        for (int ct = 0; ct < 8; ++ct)
#pragma unroll
          for (int tt = 0; tt < 4; ++tt) {
            const int row = rbase + tt * 16, col = cbase + ct * 16;
            *(uint2*)(BIG + (size_t)row * 2560 + col) = uint2{pack2(acc[ct][tt][0], acc[ct][tt][1]), pack2(acc[ct][tt][2], acc[ct][tt][3])};
          }
      });
      grid.sync();
      hgrn_h1(P, l, smem);
      grid.sync();
      hgrn_h2(P, smem);
      grid.sync();
      hgrn_h3(P, l, nrows2);
      grid.sync();
      gemm_phase<true>(HB, 1024, WB + W_IN + (size_t)2560 * 1024, 1024, 1024, RA, 1536, smem, [&](f32x4 (&acc)[4][4], int rbase, int cbase) {
#pragma unroll
        for (int ct = 0; ct < 4; ++ct)
#pragma unroll
          for (int tt = 0; tt < 4; ++tt) {
            const int row = rbase + tt * 16, col = cbase + ct * 16;
            u16* dst = row < RL ? BIG + ((size_t)((row >> 13) * 1536 + col) << 13) + (row & 8191)
                                : BIG + (size_t)4 * 1536 * 8192 + ((size_t)(((row - RL) >> 8) * 1536 + col) << 8) + (row & 255);
            *(uint2*)dst = uint2{pack2(acc[ct][tt][0], acc[ct][tt][1]), pack2(acc[ct][tt][2], acc[ct][tt][3])};
          }
      });
      grid.sync();
      hyena_phase(P, l, smem);
      if (l == 0) hyena_ctx_phase(P, l, smem);
      grid.sync();
      gemm_phase(HB, 1024, WB + W_IN + (size_t)4096 * 1024, 1024, 1024, RA, 448, smem, [&](f32x4 (&acc)[4][4], int rbase, int cbase) {
#pragma unroll
        for (int ct = 0; ct < 4; ++ct)
#pragma unroll
          for (int tt = 0; tt < 4; ++tt) {
            const int row = rbase + tt * 16, col = cbase + ct * 16;
            if (col < 448) *(uint2*)(BIG + (size_t)row * 448 + col) = uint2{pack2(acc[ct][tt][0], acc[ct][tt][1]), pack2(acc[ct][tt][2], acc[ct][tt][3])};
          }
      });
      grid.sync();
      mla_e1(P, l);
      grid.sync();
      {
        u16* Qb = (u16*)(P.ws + OFF_BIG + BIG_Q);
        u16* Kb = (u16*)(P.ws + OFF_BIG + BIG_K);
        u16* Vb = (u16*)(P.ws + OFF_BIG + BIG_VT);
        gemm_phase(BIG, 448, WB + W_UQ, 256, 256, RA, 768, smem, [&](f32x4 (&acc)[4][4], int rbase, int cbase) {
#pragma unroll
          for (int ct = 0; ct < 4; ++ct)
#pragma unroll
            for (int tt = 0; tt < 4; ++tt) {
              const int row = rbase + tt * 16, col = cbase + ct * 16;
              *(uint2*)(Qb + (size_t)row * 768 + col) = uint2{pack2(acc[ct][tt][0], acc[ct][tt][1]), pack2(acc[ct][tt][2], acc[ct][tt][3])};
            }
        });
        gemm_phase(BIG + 256, 448, WB + W_UKV, 128, 128, RA, 512, smem, [&](f32x4 (&acc)[4][4], int rbase, int cbase) {
#pragma unroll
          for (int ct = 0; ct < 4; ++ct)
#pragma unroll
            for (int tt = 0; tt < 4; ++tt) {
              const int row = rbase + tt * 16, col = cbase + ct * 16;
              const int hh = col >> 8, jj = col & 255;
              *(uint2*)(Kb + (size_t)row * 768 + hh * 192 + jj) = uint2{pack2(acc[ct][tt][0], acc[ct][tt][1]), pack2(acc[ct][tt][2], acc[ct][tt][3])};
            }
        }, 2, 0);
        gemm_phase<true>(BIG + 256, 448, WB + W_UKV, 128, 128, RA, 512, smem, [&](f32x4 (&acc)[4][4], int rbase, int cbase) {
#pragma unroll
          for (int ct = 0; ct < 4; ++ct)
#pragma unroll
            for (int tt = 0; tt < 4; ++tt) {
              const int row = rbase + tt * 16, col = cbase + ct * 16;
              const int hh = col >> 8, dv = (col & 255) - 128;
              int bb, kt;
              if (row < RL) { bb = row >> 13; kt = (row & 8191) >> 6; } else { int rc = row - RL; bb = rc >> 8; kt = 128 + ((rc & 255) >> 6); }
              u16* vp = Vb + (((size_t)(bb * 132 + kt) * 4 + hh) * 128 + dv) * 64 + (row & 63);
              *(uint2*)vp = uint2{pack2(acc[ct][tt][0], acc[ct][tt][1]), pack2(acc[ct][tt][2], acc[ct][tt][3])};
            }
        }, 2, 1);
      }
      grid.sync();
      mla_e2(P, l);
      grid.sync();
      attn_phase(P, l == 0, smem);
      grid.sync();
      gemm_phase2(HB, 1024, WB + W_IN + (size_t)4544 * 1024, 1024, 1024, nrows2, 3072, smem, [&](f32x4 (&acc)[8][4], int rbase, int cbase) {
#pragma unroll
        for (int ct = 0; ct < 8; ++ct)
#pragma unroll
          for (int tt = 0; tt < 4; ++tt) {
            const int row = rbase + tt * 16, col = cbase + ct * 16;
            *(uint2*)(BIG + (size_t)row * 3072 + col) = uint2{pack2(sigmf(acc[ct][tt][0]), sigmf(acc[ct][tt][1])), pack2(sigmf(acc[ct][tt][2]), sigmf(acc[ct][tt][3]))};
          }
      });
      grid.sync();
      {
        const int ntm = nrows2 >> 8;
        const int tid_ = otid(), lane = tid_ & 63, w = tid_ >> 6, wt = w & 3, wc = w >> 2;
        const TileIter ti(ntm, 8);
        for (int i = 0; i < ti.ntot_it; ++i) {
          int rt_, ct_;
          ti.get(i, rt_, ct_);
          const int row0 = rt_ * 256, col0 = ct_ * 128;
          const int rbase = row0 + wt * 64 + (lane & 15), cbase = col0 + wc * 64 + (lane >> 4) * 4;
          for (int x = 0; x < 3; ++x) {
            f32x4 acc[4][4];
            zero_acc(acc);
            const u16* Yx = x == 0 ? YA : x == 1 ? YB : YC;
            gemm_main(acc, Yx, 512, WB + W_BRA + (size_t)x * 524288, 512, 512, row0, col0, smem);
#pragma unroll
            for (int tt = 0; tt < 4; ++tt) {
              const int row = rbase + tt * 16;
              const u16* gp = BIG + (size_t)row * 3072 + x * 1024 + cbase;
              uint2* mp = (uint2*)(HB + (size_t)row * 1024 + cbase);
              uint2 g[4], o[4];
#pragma unroll
              for (int ct = 0; ct < 4; ++ct) { g[ct] = *(const uint2*)(gp + ct * 16); o[ct] = x > 0 ? mp[ct * 4] : uint2{0u, 0u}; }
              __builtin_amdgcn_sched_barrier(0);
#pragma unroll
              for (int ct = 0; ct < 4; ++ct) {
                const float m0 = blo(g[ct].x) * acc[ct][tt][0] + blo(o[ct].x), m1 = bhi(g[ct].x) * acc[ct][tt][1] + bhi(o[ct].x);
                const float m2 = blo(g[ct].y) * acc[ct][tt][2] + blo(o[ct].y), m3 = bhi(g[ct].y) * acc[ct][tt][3] + bhi(o[ct].y);
                g[ct] = uint2{pack2(m0, m1), pack2(m2, m3)};
              }
#pragma unroll
              for (int ct = 0; ct < 4; ++ct) mp[ct * 4] = g[ct];
            }
          }
        }
      }
      grid.sync();
      gemm_phase(HB, 1024, WB + W_OUT, 1024, 1024, nrows2, 1024, smem, [&](f32x4 (&acc)[4][4], int rbase, int cbase) {
        float4 g[4];
        const float* mdp = modp(P, l, rbase) + 5 * 1024 + cbase;
#pragma unroll
        for (int ct = 0; ct < 4; ++ct) g[ct] = *(const float4*)(mdp + ct * 16);
#pragma unroll
        for (int tt = 0; tt < 4; ++tt) {
          float4* xp = (float4*)(xrow(P, rbase + tt * 16) + cbase);
          float4 xv[4];
#pragma unroll
          for (int ct = 0; ct < 4; ++ct) xv[ct] = xp[ct * 4];
          __builtin_amdgcn_sched_barrier(0);
#pragma unroll
          for (int ct = 0; ct < 4; ++ct) {
            xv[ct].x += g[ct].x * acc[ct][tt][0]; xv[ct].y += g[ct].y * acc[ct][tt][1];
            xv[ct].z += g[ct].z * acc[ct][tt][2]; xv[ct].w += g[ct].w * acc[ct][tt][3];
          }
#pragma unroll
          for (int ct = 0; ct < 4; ++ct) xp[ct * 4] = xv[ct];
        }
      });
      grid.sync();
    }
    norm_phase(P, l, 2, nrows2, false);
    grid.sync();
    ffn_phases(P, grid, l, 1, nrows2, smem);
  }
}

extern "C" void kernel_launch(void* const* d_in, const int* in_sizes, int n_in, void* d_out, int out_size, void* d_ws, size_t ws_size,
                              hipStream_t stream) {
  static int grid_blocks = 0;
  if (!grid_blocks) {
    int dev = 0, cus = 0, per_cu = 0;
    hipGetDevice(&dev);
    hipDeviceGetAttribute(&cus, hipDeviceAttributeMultiprocessorCount, dev);
    hipFuncSetAttribute((const void*)fwd_megakernel, hipFuncAttributeMaxDynamicSharedMemorySize, LDS_BYTES);
    hipOccupancyMaxActiveBlocksPerMultiprocessor(&per_cu, (const void*)fwd_megakernel, NTHR, LDS_BYTES);
    if (per_cu < 1) { fprintf(stderr, "occupancy query says %d blocks/CU\n", per_cu); per_cu = 1; }
    grid_blocks = (cus & ~7);
    if (ws_size < WS_NEED) fprintf(stderr, "workspace too small: %zu < %zu\n", ws_size, (size_t)WS_NEED);
  }
  Params p{};
  for (int i = 0; i < 39; ++i) p.in[i] = (const float*)d_in[i];
  p.out = (float*)d_out;
  p.ws = (unsigned char*)d_ws;
  (void)hipMemsetAsync((unsigned char*)d_ws + OFF_BAR, 0, 16384, stream);
  void* args[] = {&p};
  hipError_t e = hipLaunchCooperativeKernel((const void*)fwd_megakernel, dim3(grid_blocks), dim3(NTHR), args, LDS_BYTES, stream);
  if (e != hipSuccess) fprintf(stderr, "cooperative launch failed: %s (grid %d)\n", hipGetErrorString(e), grid_blocks);
}
```
